# Optimizing an MI355X kernel written in HIP

```python
import jax, jax.numpy as jnp
from jax import lax
import numpy as np

D_MODEL = 2048
BATCH = 1
SEQ = 16384
DEPTH = 4

PLE_DIM = 256
D_FF = 4 * D_MODEL
MIX_WIDTH = D_MODEL
HG_WIDTH = MIX_WIDTH // 2
HG_HEAD_DIM = 128
HG_HEADS = HG_WIDTH // HG_HEAD_DIM
GLA_WIDTH = MIX_WIDTH - HG_WIDTH
GLA_HEADS = 4
GLA_DV = GLA_WIDTH // GLA_HEADS
GLA_DK = GLA_DV // 2
GLA_KEY_WIDTH = GLA_HEADS * GLA_DK
GLA_GATE_RANK = 16
GLA_GATE_NORM = 16.0
CONV_WIDTH = 4
CHUNK = 64
EPS = 1e-6

SPLIT_POINTS = (
    HG_WIDTH,
    2 * HG_WIDTH,
    3 * HG_WIDTH,
    4 * HG_WIDTH,
    4 * HG_WIDTH + GLA_KEY_WIDTH,
    4 * HG_WIDTH + 2 * GLA_KEY_WIDTH,
    4 * HG_WIDTH + 2 * GLA_KEY_WIDTH + GLA_WIDTH,
    4 * HG_WIDTH + 2 * GLA_KEY_WIDTH + 2 * GLA_WIDTH,
)
IN_WIDTH = 4 * HG_WIDTH + 2 * GLA_KEY_WIDTH + 2 * GLA_WIDTH + GLA_GATE_RANK
CONV_CH = 2 * GLA_KEY_WIDTH + GLA_WIDTH

kernel_name = "hgrn2_gla_parallel_hybrid"


def rmsnorm(x, g):
    xf = x.astype(jnp.float32)
    y = xf * lax.rsqrt(jnp.mean(xf * xf, axis=-1, keepdims=True) + EPS)
    return (y * g.astype(jnp.float32)).astype(x.dtype)


def head_rmsnorm(o, g):
    B, S, H, dv = o.shape
    y = o * lax.rsqrt(jnp.mean(o * o, axis=-1, keepdims=True) + EPS)
    return (y * g.astype(jnp.float32).reshape(H, dv)).reshape(B, S, H * dv)


def causal_short_conv(x, w):
    S = x.shape[1]
    xp = jnp.pad(x, ((0, 0), (CONV_WIDTH - 1, 0), (0, 0)))
    return sum(xp[:, j:j + S] * w[j] for j in range(CONV_WIDTH))


def chunked_gated_recurrence(q, k, v, log_a):
    B, S, H, dk = q.shape
    dv = v.shape[-1]
    n = S // CHUNK

    def to_chunks(t):
        return t.astype(jnp.float32).reshape(B, n, CHUNK, H, t.shape[-1]).transpose(1, 0, 3, 2, 4)

    qc, kc, vc, ac = to_chunks(q), to_chunks(k), to_chunks(v), to_chunks(log_a)
    causal = jnp.tril(jnp.ones((CHUNK, CHUNK), dtype=bool))[:, :, None]

    def step(state, inp):
        qi, ki, vi, ai = inp
        b = jnp.cumsum(ai, axis=2)
        diff = b[:, :, :, None, :] - b[:, :, None, :, :]
        decay = jnp.exp(jnp.where(causal, diff, -jnp.inf))
        scores = jnp.einsum('bhtc,bhsc,bhtsc->bhts', qi, ki, decay)
        o_intra = jnp.einsum('bhts,bhsv->bhtv', scores, vi)
        o_inter = jnp.einsum('bhtc,bhcv->bhtv', qi * jnp.exp(b), state)
        b_last = b[:, :, -1:, :]
        k_dec = ki * jnp.exp(b_last - b)
        new_state = jnp.exp(b_last[:, :, 0, :])[..., None] * state + jnp.einsum('bhsc,bhsv->bhcv', k_dec, vi)
        return new_state, o_intra + o_inter

    state0 = jnp.zeros((B, H, dk, dv), jnp.float32)
    _, o = lax.scan(step, state0, (qc, kc, vc, ac))
    return o.transpose(1, 0, 3, 2, 4).reshape(B, S, H, dv)


def setup_inputs(seed: int = 0) -> dict:
    key = jax.random.key(seed)
    ks = jax.random.split(key, 24)
    f32 = jnp.float32

    def nrm(k, shape, scale):
        return jax.random.normal(k, shape, f32) * scale

    def gain(k, shape):
        return 1.0 + 0.02 * jax.random.normal(k, shape, f32)

    return {
        "x": nrm(ks[0], (BATCH, SEQ, D_MODEL), 1.0),
        "p": nrm(ks[1], (DEPTH, BATCH, SEQ, PLE_DIM), 1.0),
        "g_mix": gain(ks[2], (DEPTH, D_MODEL)),
        "w_in": nrm(ks[3], (DEPTH, D_MODEL, IN_WIDTH), D_MODEL ** -0.5),
        "lb_logits": nrm(ks[4], (DEPTH, HG_WIDTH), 1.0),
        "g_hg_norm": gain(ks[5], (DEPTH, HG_WIDTH)),
        "conv_w": nrm(ks[6], (DEPTH, CONV_WIDTH, CONV_CH), CONV_WIDTH ** -0.5),
        "w_gla_gate": nrm(ks[7], (DEPTH, GLA_GATE_RANK, GLA_KEY_WIDTH), GLA_GATE_RANK ** -0.5),
        "b_gla_gate": nrm(ks[8], (DEPTH, GLA_KEY_WIDTH), 0.1),
        "g_gla_norm": gain(ks[9], (DEPTH, GLA_WIDTH)),
        "w_out": nrm(ks[10], (DEPTH, MIX_WIDTH, D_MODEL), MIX_WIDTH ** -0.5),
        "g_mlp": gain(ks[11], (DEPTH, D_MODEL)),
        "w_up": nrm(ks[12], (DEPTH, D_MODEL, D_FF), D_MODEL ** -0.5),
        "w_down": nrm(ks[13], (DEPTH, D_FF, D_MODEL), D_FF ** -0.5),
        "g_ple": gain(ks[14], (DEPTH, D_MODEL)),
        "w_pg": nrm(ks[15], (DEPTH, D_MODEL, D_MODEL), D_MODEL ** -0.5),
        "w_pp": nrm(ks[16], (DEPTH, PLE_DIM, D_MODEL), PLE_DIM ** -0.5),
        "g_final": gain(ks[17], (D_MODEL,)),
    }


def reference(x, p, g_mix, w_in, lb_logits, g_hg_norm, conv_w, w_gla_gate, b_gla_gate,
              g_gla_norm, w_out, g_mlp, w_up, w_down, g_ple, w_pg, w_pp, g_final):
    f32 = jnp.float32
    B, S, _ = x.shape
    lb_cum = jnp.cumsum(jax.nn.softmax(lb_logits.astype(f32), axis=0), axis=0)
    h = x
    for l in range(DEPTH):
        u = rmsnorm(h, g_mix[l])
        z = u @ w_in[l]
        hq, hf, hi, hg, gq, gk, gv, gr, ga = jnp.split(z, SPLIT_POINTS, axis=-1)

        lb = lb_cum[l] - lb_cum[0]
        log_f = jnp.logaddexp(jnp.log(lb), jnp.log1p(-lb) + jax.nn.log_sigmoid(hf.astype(f32)))
        k_h = -jnp.expm1(log_f)
        hs = (B, S, HG_HEADS, HG_HEAD_DIM)
        o_h = chunked_gated_recurrence(hq.reshape(hs), k_h.reshape(hs), hi.reshape(hs), log_f.reshape(hs))
        y_h = head_rmsnorm(o_h, g_hg_norm[l]) * jax.nn.silu(hg.astype(f32))

        qkv = jax.nn.silu(causal_short_conv(jnp.concatenate([gq, gk, gv], axis=-1), conv_w[l]))
        cq, ck, cv = jnp.split(qkv, (GLA_KEY_WIDTH, 2 * GLA_KEY_WIDTH), axis=-1)
        log_alpha = jax.nn.log_sigmoid((ga @ w_gla_gate[l] + b_gla_gate[l]).astype(f32)) / GLA_GATE_NORM
        ks_ = (B, S, GLA_HEADS, GLA_DK)
        o_g = chunked_gated_recurrence((cq * GLA_DK ** -0.5).reshape(ks_), ck.reshape(ks_),
                                       cv.reshape(B, S, GLA_HEADS, GLA_DV), log_alpha.reshape(ks_))
        y_g = head_rmsnorm(o_g, g_gla_norm[l]) * jax.nn.silu(gr.astype(f32))

        y = jnp.concatenate([y_h, y_g], axis=-1).astype(h.dtype)
        h = h + y @ w_out[l]

        m = rmsnorm(h, g_mlp[l]) @ w_up[l]
        h = h + jnp.square(jax.nn.relu(m)) @ w_down[l]

        gate = jax.nn.sigmoid(rmsnorm(h, g_ple[l]) @ w_pg[l])
        h = h + gate * (p[l] @ w_pp[l])
    return rmsnorm(h, g_final)
```

```cpp
#include <hip/hip_runtime.h>
#include <cstdio>
#include <cstdint>

#ifndef PROBE_GEMM
#define PROBE_GEMM 0
#endif
#ifndef PROBE_MIX
#define PROBE_MIX 0
#endif
#ifndef PROBE_BAR
#define PROBE_BAR 0
#endif
#ifndef PROBE_SCAN
#define PROBE_SCAN 0
#endif
#ifndef PROBE_GEMMR
#define PROBE_GEMMR 0
#endif
#ifndef PROBE_PRO
#define PROBE_PRO 0
#endif
#ifndef PROBE_G5
#define PROBE_G5 0
#endif
#ifndef MK_MULTI
#define MK_MULTI 0
#endif

namespace pg8 {
#define PG8_LAS __attribute__((address_space(3)))
typedef unsigned short bf16_t;
typedef short bf16x8 __attribute__((ext_vector_type(8)));
typedef float f32x4 __attribute__((ext_vector_type(4)));
typedef unsigned u32x4 __attribute__((ext_vector_type(4)));
typedef unsigned u32x2 __attribute__((ext_vector_type(2)));
constexpr int BM = 256, BK = 64, HALF = 128, HTB = HALF * BK * 2  , STAGE_BYTES = 8 * HTB, NXCD = 8, WGM = 8;

__host__ __device__ __forceinline__ int lds_byte(int r, int c) { const int st = (r >> 4) * 2 + (c >> 5), rr = r & 15, cc = c & 31, ob = rr * 64 + cc * 2; return st * 1024 + (ob ^ (((ob >> 9) & 1) << 5)); }
__host__ __device__ __forceinline__ void stage_rc(int b, int& R, int& C) { const int st = b / 1024, sb = b % 1024, swz = sb ^ (((sb >> 9) & 1) << 5); R = (st >> 1) * 16 + swz / 64; C = (st & 1) * 32 + (swz % 64) / 2; }
__host__ __device__ __forceinline__ int perm32(int rho) { const int n = rho >> 4, i = rho & 15; return 8 * (i >> 2) + 4 * n + (i & 3); }

struct Unit { int pm, pn; };
struct Gemm { const bf16_t* A; const bf16_t* Bt; int M, N, K; };

struct StaticOrder {
    int nM, nN, nwg, G, c, wgm;
    __host__ __device__ void init(int M, int N, int G_, int c_, int wgm_ = WGM) { nM = M / BM; nN = N / BM; nwg = nM * nN; G = G_; c = c_; wgm = wgm_; }
    __host__ __device__ bool next(int i, Unit& u) const {
        const long L = (long)i * G + c; if (L >= nwg) return false;
        int wgid = (int)L; { const int q = nwg / NXCD, r = nwg % NXCD, xcd = wgid % NXCD, off = wgid / NXCD; wgid = (xcd < r ? xcd * (q + 1) : r * (q + 1) + (xcd - r) * q) + off; }
        const int nig = wgm * nN, gid = wgid / nig, fm = gid * wgm, gsz = (nM - fm) < wgm ? (nM - fm) : wgm;
        u.pm = fm + ((wgid % nig) % gsz); u.pn = (wgid % nig) / gsz; return true;
    }
    __device__ __forceinline__ void a_ready(const Unit&) const {}
    __device__ __forceinline__ void done(const Unit&) const {}
};

typedef __bf16 bf16x2_t __attribute__((ext_vector_type(2)));
typedef float f32x2_t __attribute__((ext_vector_type(2)));
__device__ __forceinline__ unsigned cvt_pk_bf16(float lo, float hi) { const f32x2_t f = {lo, hi}; const bf16x2_t b = __builtin_convertvector(f, bf16x2_t); return __builtin_bit_cast(unsigned, b); }
__device__ __forceinline__ float bf_lo(unsigned w) { return __uint_as_float(w << 16); }
__device__ __forceinline__ float bf_hi(unsigned w) { return __uint_as_float(w & 0xffff0000u); }
__device__ __forceinline__ unsigned cvt_pk_fp8x4(float a, float b, float c, float d) { int w = 0; w = __builtin_amdgcn_cvt_pk_fp8_f32(a, b, w, false); w = __builtin_amdgcn_cvt_pk_fp8_f32(c, d, w, true); return (unsigned)w; }
typedef int i32x4_t __attribute__((ext_vector_type(4)));
typedef int i32x8_t __attribute__((ext_vector_type(8)));
__device__ __forceinline__ i32x8_t cat8(bf16x8 lo, bf16x8 hi) { const i32x4_t a = __builtin_bit_cast(i32x4_t, lo), b = __builtin_bit_cast(i32x4_t, hi); return __builtin_shufflevector(a, b, 0, 1, 2, 3, 4, 5, 6, 7); }
__device__ __forceinline__ float sum_xor16(float v) { const unsigned b = __builtin_bit_cast(unsigned, v); const auto r = __builtin_amdgcn_permlane16_swap(b, b, false, false); return __builtin_bit_cast(float, (unsigned)r[0]) + __builtin_bit_cast(float, (unsigned)r[1]); }
__device__ __forceinline__ float sum_xor32(float v) { const unsigned b = __builtin_bit_cast(unsigned, v); const auto r = __builtin_amdgcn_permlane32_swap(b, b, false, false); return __builtin_bit_cast(float, (unsigned)r[0]) + __builtin_bit_cast(float, (unsigned)r[1]); }
template <int CTRL> __device__ __forceinline__ float dpp_get(float v) { return __builtin_bit_cast(float, __builtin_amdgcn_mov_dpp(__builtin_bit_cast(int, v), CTRL, 0xF, 0xF, true)); }
__device__ __forceinline__ float get_xor1(float v) { return __builtin_bit_cast(float, __builtin_amdgcn_mov_dpp(__builtin_bit_cast(int, v), 0xB1, 0xF, 0xF, true)); }
constexpr float F8_WSCALE = 64.0f;

constexpr float RMS_EPS = 1e-6f;
constexpr int DMODEL = 2048;
constexpr int NSTAT = 32;

__device__ __forceinline__ void rstd_table(const float* stats, int pm, int wid, int lane, PG8_LAS float* tab) {
    const int t = wid * 64 + lane, row = t >> 1, half = t & 1;
    const f32x4* p = (const f32x4*)(stats + (size_t)(pm * BM + row) * NSTAT + half * 16);
    const f32x4 a = p[0], b = p[1], c = p[2], d = p[3];
    float s = (((a[0] + a[1]) + (a[2] + a[3])) + ((b[0] + b[1]) + (b[2] + b[3]))) + (((c[0] + c[1]) + (c[2] + c[3])) + ((d[0] + d[1]) + (d[2] + d[3])));
    s += get_xor1(s);
    if (half == 0) tab[row] = __builtin_amdgcn_rsqf(s * (1.0f / DMODEL) + RMS_EPS);
}

__host__ __device__ __forceinline__ size_t tile_rc(int row, int col, int ld) { return (((size_t)(row >> 4) * (ld >> 5) + (col >> 5)) << 9) + (row & 15) * 32 + (col & 31); }
__device__ __forceinline__ size_t tiled_off(int row, int ldc, int pn, int wc, int bj, int fq) { return (((size_t)(row >> 4) * (ldc >> 5) + pn * 8 + wc + bj * 4) << 9) + (row & 15) * 32 + 8 * fq; }
template <int ACT, bool TILED = false> struct EpiScaleBf16 {
    static constexpr bool PERM = true, AFTER_DRAIN = false;
    bf16_t* O; int ldc; const float* stats; PG8_LAS float* tab;
    __device__ __forceinline__ void prepare(const Unit& u, int wid, int lane, int par) const { if (ACT != 2) rstd_table(stats, u.pm, wid, lane, tab + par * 256); }
    __device__ __forceinline__ void operator()(const f32x4 (&acc)[2][2][4][2], const Unit& u, int wr, int wc, int fr, int fq, int wid, int lane, int par) const {
        const int rl0 = wr * 64 + fr, col0 = u.pn * BM + wc * 32 + 8 * fq;
#pragma unroll
        for (int ai = 0; ai < 2; ++ai)
#pragma unroll
            for (int m = 0; m < 4; ++m) { const int rl = rl0 + ai * HALF + m * 16; bf16_t* rowp = O + (size_t)(u.pm * BM + rl) * ldc + col0;
                float sc = 1.0f; if (ACT != 2) sc = tab[par * 256 + rl];
#pragma unroll
                for (int bj = 0; bj < 2; ++bj) { f32x4 v0 = acc[ai][bj][m][0] * sc, v1 = acc[ai][bj][m][1] * sc;
                    if (ACT == 1) {
#pragma unroll
                        for (int j = 0; j < 4; ++j) { const float a0 = fmaxf(v0[j], 0.f), a1 = fmaxf(v1[j], 0.f); v0[j] = a0 * a0; v1[j] = a1 * a1; } }
                    u32x4 w; w.x = cvt_pk_bf16(v0[0], v0[1]); w.y = cvt_pk_bf16(v0[2], v0[3]); w.z = cvt_pk_bf16(v1[0], v1[1]); w.w = cvt_pk_bf16(v1[2], v1[3]);
                    if constexpr (TILED) {
                        const int row = u.pm * BM + rl;
                        *(u32x4*)(O + (((size_t)(row >> 4) * (ldc >> 5) + u.pn * 8 + wc + bj * 4) << 9) + (row & 15) * 32 + 8 * fq) = w;
                    } else *(u32x4*)(rowp + bj * HALF) = w; } }
    }
};

template <int MODE> struct EpiResidual {
    static constexpr bool PERM = true, AFTER_DRAIN = false;
    const bf16_t* hin; bf16_t* hout; float* stats_out; const float* stats_in; const bf16_t* pp; int ldc; PG8_LAS float* tab; unsigned char* h8;
    __device__ __forceinline__ void prepare(const Unit& u, int wid, int lane, int par) const { if (MODE == 1) rstd_table(stats_in, u.pm, wid, lane, tab + par * 256); }
    __device__ __forceinline__ void operator()(const f32x4 (&acc)[2][2][4][2], const Unit& u, int wr, int wc, int fr, int fq, int wid, int lane, int par) const {
        const int rl0 = wr * 64 + fr, col0 = u.pn * BM + wc * 32 + 8 * fq;
#pragma unroll
        for (int ai = 0; ai < 2; ++ai) {
            u32x4 hv[4][2], pw[4][2];
#pragma unroll
            for (int m = 0; m < 4; ++m) { const size_t off = (size_t)(u.pm * BM + rl0 + ai * HALF + m * 16) * ldc + col0;
#pragma unroll
                for (int bj = 0; bj < 2; ++bj) { hv[m][bj] = *(const u32x4*)(hin + tiled_off(u.pm * BM + rl0 + ai * HALF + m * 16, ldc, u.pn, wc, bj, fq)); if (MODE == 1) pw[m][bj] = *(const u32x4*)(pp + tiled_off(u.pm * BM + rl0 + ai * HALF + m * 16, ldc, u.pn, wc, bj, fq)); } }
#pragma unroll
            for (int m = 0; m < 4; ++m) { const int rl = rl0 + ai * HALF + m * 16, row = u.pm * BM + rl; const size_t off = (size_t)row * ldc + col0; float ss = 0.f;
                float sc2 = 0.f; if (MODE == 1) sc2 = tab[par * 256 + rl] * (-1.4426950408889634f / F8_WSCALE);
#pragma unroll
                for (int bj = 0; bj < 2; ++bj) {
                    f32x4 v0 = acc[ai][bj][m][0], v1 = acc[ai][bj][m][1];
                    if (MODE == 1) {
                        const u32x4 q = pw[m][bj];
                        const float pv[8] = {bf_lo(q.x), bf_hi(q.x), bf_lo(q.y), bf_hi(q.y), bf_lo(q.z), bf_hi(q.z), bf_lo(q.w), bf_hi(q.w)};
#pragma unroll
                        for (int j = 0; j < 4; ++j) {
                            const float g0 = __builtin_amdgcn_rcpf(1.0f + __builtin_amdgcn_exp2f(v0[j] * sc2)), g1 = __builtin_amdgcn_rcpf(1.0f + __builtin_amdgcn_exp2f(v1[j] * sc2));
                            v0[j] = g0 * pv[j]; v1[j] = g1 * pv[4 + j]; }
                    }
                    const u32x4 h = hv[m][bj];
                    v0 = v0 + (f32x4){bf_lo(h.x), bf_hi(h.x), bf_lo(h.y), bf_hi(h.y)}; v1 = v1 + (f32x4){bf_lo(h.z), bf_hi(h.z), bf_lo(h.w), bf_hi(h.w)};
                    u32x4 w; w.x = cvt_pk_bf16(v0[0], v0[1]); w.y = cvt_pk_bf16(v0[2], v0[3]); w.z = cvt_pk_bf16(v1[0], v1[1]); w.w = cvt_pk_bf16(v1[2], v1[3]);
                    *(u32x4*)(hout + tiled_off(row, ldc, u.pn, wc, bj, fq)) = w;
                    if (MODE == 2) { u32x2 w8; w8.x = cvt_pk_fp8x4(v0[0], v0[1], v0[2], v0[3]); w8.y = cvt_pk_fp8x4(v1[0], v1[1], v1[2], v1[3]); const int bc = u.pn * BM + bj * HALF + wc * 32 + 8 * fq;
                        *(u32x2*)(h8 + ((((size_t)(row >> 4) * (ldc >> 6)) + (bc >> 6)) << 10) + (row & 15) * 64 + (bc & 63)) = w8; }
                    ss += (v0[0] * v0[0] + v0[1] * v0[1]) + (v0[2] * v0[2] + v0[3] * v0[3]) + (v1[0] * v1[0] + v1[1] * v1[1]) + (v1[2] * v1[2] + v1[3] * v1[3]);
                }
                ss = sum_xor16(ss); ss = sum_xor32(ss);
                if (fq == 0) stats_out[(size_t)row * NSTAT + u.pn * 4 + wc] = ss;
            }
            asm volatile("" ::: "memory");
        }
    }
};

struct EpiNull { static constexpr bool PERM = true, AFTER_DRAIN = false;
    __device__ __forceinline__ void prepare(const Unit&, int, int, int) const {}
    __device__ __forceinline__ void operator()(const f32x4 (&acc)[2][2][4][2], const Unit&, int, int, int, int, int, int, int) const {
#pragma unroll
        for (int a = 0; a < 2; ++a)
#pragma unroll
            for (int b = 0; b < 2; ++b)
#pragma unroll
                for (int m = 0; m < 4; ++m)
#pragma unroll
                    for (int n = 0; n < 2; ++n) asm volatile("" :: "v"(acc[a][b][m][n])); } };
__device__ __forceinline__ int fresh_lane() { int l; asm volatile("v_mbcnt_lo_u32_b32 %0, -1, 0\n\tv_mbcnt_hi_u32_b32 %0, -1, %0" : "=v"(l)); return l; }
template <class Epi, class Sched, bool ALIGN_EPI = false, bool SP2 = false, bool FP8 = false, bool ATILED = false, bool BTILED = true>
__device__ __forceinline__ void gemm_phase(PG8_LAS unsigned char* lds, const int wid_in, const Gemm g, const Sched& S, const Epi& E) {
    int wid = wid_in; asm volatile("" : "+s"(wid));
    const int lane = fresh_lane(), tid = wid * 64 + lane, wr = wid >> 2, wc = wid & 3, fr = lane & 15, fq = lane >> 4;
    const int K = g.K, nt = K / BK;
    unsigned voffA[2], voffB[2];
#pragma unroll
    for (int i = 0; i < 2; ++i) { int R, C; stage_rc(tid * 16 + i * 8192, R, C); const int Rb = Epi::PERM ? ((R & ~31) + perm32(R & 31)) : R;
        voffA[i] = ATILED ? (unsigned)((((R >> 4) * (K >> 5) + (C >> 5)) << 10) + (R & 15) * 64 + (C & 31) * 2) : (unsigned)(R * K + C) * 2u; voffB[i] = BTILED ? (unsigned)((((R >> 4) * (K >> 5) + (C >> 5)) << 10) + (R & 15) * 64 + (C & 31) * 2) : (unsigned)(Rb * K + C) * 2u; }
    const size_t kstep = (size_t)(BK * 2);
    const size_t kstepA = ATILED ? (size_t)2048 : kstep;
    const size_t kstepB = BTILED ? (size_t)2048 : kstep;
    const size_t hstep = (size_t)HALF * K * 2;
    const size_t tstep = 2 * hstep;
    const unsigned ldsw = (unsigned)wid * 1024u;
    const int aoff = lds_byte(wr * 64 + fr, fq * 8), boff = lds_byte(wc * 32 + fr, fq * 8);
#define PG8_SA(b, h) (((b) * 2 + (h)) * HTB)
#define PG8_SB(b, h) ((4 + (b) * 2 + (h)) * HTB)
#define PG8_STAGE(bufoff, gbase, voff) do { _Pragma("unroll") for (int _i = 0; _i < 2; ++_i) { unsigned _vo = (voff)[_i]; if constexpr (FP8) asm volatile("" : "+v"(_vo));    \
        __builtin_amdgcn_global_load_lds((const unsigned*)((const char*)(gbase) + _vo), (PG8_LAS unsigned*)(lds + (bufoff) + ldsw + _i * 8192), 16, 0, 0); } } while (0)
#define PG8_LDA(dst, b, h) do { _Pragma("unroll") for (int m = 0; m < 4; ++m) _Pragma("unroll") for (int k = 0; k < 2; ++k) dst[m][k] = *(const PG8_LAS bf16x8*)(lds + PG8_SA(b, h) + aoff + m * 2048 + k * 1024); } while (0)
#define PG8_LDB(dst, b, h) do { _Pragma("unroll") for (int n = 0; n < 2; ++n) _Pragma("unroll") for (int k = 0; k < 2; ++k) dst[n][k] = *(const PG8_LAS bf16x8*)(lds + PG8_SB(b, h) + boff + n * 2048 + k * 1024); } while (0)
#define PG8_MMA(ai, bj, At, Bt) do { __builtin_amdgcn_s_setprio(1); _Pragma("unroll") for (int m = 0; m < 4; ++m) _Pragma("unroll") for (int n = 0; n < 2; ++n) { \
        if constexpr (FP8) acc[ai][bj][m][n] = __builtin_amdgcn_mfma_scale_f32_16x16x128_f8f6f4(cat8(Bt[n][0], Bt[n][1]), cat8(At[m][0], At[m][1]), acc[ai][bj][m][n], 0, 0, 0, 0, 0, 0);   \
        else { _Pragma("unroll") for (int k = 0; k < 2; ++k) acc[ai][bj][m][n] = __builtin_amdgcn_mfma_f32_16x16x32_bf16(Bt[n][k], At[m][k], acc[ai][bj][m][n], 0, 0, 0); } } \
        __builtin_amdgcn_s_setprio(0); } while (0)
#define PG8_WAIT_V(n) asm volatile("s_waitcnt vmcnt(" #n ")" ::: "memory")
#define PG8_WAIT_L(n) asm volatile("s_waitcnt lgkmcnt(" #n ")" ::: "memory")
#define PG8_BAR __builtin_amdgcn_s_barrier()
#define PG8_SCHED __builtin_amdgcn_sched_barrier(0)
    Unit cur, nxt; int ui = 0;
    if (!S.next(0, cur)) return;
    f32x4 acc[2][2][4][2];
#pragma unroll
    for (int a = 0; a < 2; ++a)
#pragma unroll
        for (int b = 0; b < 2; ++b)
#pragma unroll
            for (int m = 0; m < 4; ++m)
#pragma unroll
                for (int n = 0; n < 2; ++n) acc[a][b][m][n] = (f32x4){0.f, 0.f, 0.f, 0.f};
    bf16x8 At[4][2], B0[2][2], B1[2][2];
    const char* cA = (const char*)g.A + (size_t)cur.pm * tstep; const char* cB = (const char*)g.Bt + (size_t)cur.pn * tstep;
    S.a_ready(cur);
    if constexpr (SP2) {
        PG8_STAGE(PG8_SB(0, 0), cB, voffB); PG8_STAGE(PG8_SB(0, 1), cB + hstep, voffB); PG8_STAGE(PG8_SA(0, 0), cA, voffA); PG8_STAGE(PG8_SA(0, 1), cA + hstep, voffA);
        E.prepare(cur, wid, lane, 0);
        if (wr == 1) PG8_BAR;
        PG8_WAIT_V(2); PG8_BAR;
        PG8_STAGE(PG8_SB(1, 0), cB + kstepB, voffB); PG8_STAGE(PG8_SA(1, 0), cA + kstepA, voffA); PG8_STAGE(PG8_SB(1, 1), cB + hstep + kstepB, voffB);
        PG8_WAIT_V(6); PG8_BAR;
    } else {
        PG8_STAGE(PG8_SB(0, 0), cB, voffB); PG8_STAGE(PG8_SA(0, 0), cA, voffA); PG8_STAGE(PG8_SB(0, 1), cB + hstep, voffB); PG8_STAGE(PG8_SA(0, 1), cA + hstep, voffA);
        E.prepare(cur, wid, lane, 0);
        if (wr == 1) PG8_BAR;
        PG8_WAIT_V(4); PG8_BAR;
        PG8_STAGE(PG8_SB(1, 0), cB + kstepB, voffB); PG8_STAGE(PG8_SA(1, 0), cA + kstepA, voffA); PG8_STAGE(PG8_SB(1, 1), cB + hstep + kstepB, voffB);
        PG8_WAIT_V(6); PG8_BAR;
    }
    for (;;) {
        const bool has_next = S.next(ui + 1, nxt);
        const char* nA = has_next ? (const char*)g.A + (size_t)nxt.pm * tstep : cA; const char* nB = has_next ? (const char*)g.Bt + (size_t)nxt.pn * tstep : cB;
#pragma unroll 1
        for (int t = 0; t < nt; t += 2) {
            const bool last = (t == nt - 2);
            const char* a1 = cA + (size_t)(t + 1) * kstepA;
            const char* a2 = last ? nA : cA + (size_t)(t + 2) * kstepA; const char* b2 = last ? nB : cB + (size_t)(t + 2) * kstepB;
            const char* a3 = a2 + kstepA; const char* b3 = b2 + kstepB;
            if (last && has_next) S.a_ready(nxt);
            if constexpr (SP2) {
            PG8_LDB(B0, 0, 0); PG8_LDB(B1, 0, 1); PG8_SCHED; PG8_LDA(At, 0, 0); PG8_STAGE(PG8_SA(1, 1), a1 + hstep, voffA);
            PG8_WAIT_V(8); PG8_WAIT_L(0); PG8_BAR; PG8_MMA(0, 0, At, B0); PG8_MMA(0, 1, At, B1); PG8_BAR; PG8_SCHED;
            PG8_LDA(At, 0, 1); PG8_STAGE(PG8_SB(0, 0), b2, voffB); PG8_STAGE(PG8_SB(0, 1), b2 + hstep, voffB); PG8_STAGE(PG8_SA(0, 0), a2, voffA);
            PG8_WAIT_V(8); PG8_WAIT_L(0); PG8_BAR; PG8_MMA(1, 0, At, B0); PG8_MMA(1, 1, At, B1); PG8_BAR; PG8_SCHED;
            PG8_LDB(B0, 1, 0); PG8_LDB(B1, 1, 1); PG8_SCHED; PG8_LDA(At, 1, 0); PG8_STAGE(PG8_SA(0, 1), a2 + hstep, voffA);
            PG8_WAIT_V(8); PG8_WAIT_L(0); PG8_BAR; PG8_MMA(0, 0, At, B0); PG8_MMA(0, 1, At, B1); PG8_BAR; PG8_SCHED;
            PG8_LDA(At, 1, 1); PG8_STAGE(PG8_SB(1, 0), b3, voffB); PG8_STAGE(PG8_SB(1, 1), b3 + hstep, voffB); PG8_STAGE(PG8_SA(1, 0), a3, voffA);
            PG8_WAIT_V(8); PG8_WAIT_L(0); PG8_BAR; PG8_MMA(1, 0, At, B0); PG8_MMA(1, 1, At, B1); PG8_BAR; PG8_SCHED;
            } else {
            PG8_LDB(B0, 0, 0); PG8_SCHED; PG8_LDA(At, 0, 0); PG8_STAGE(PG8_SA(1, 1), a1 + hstep, voffA);
            PG8_WAIT_L(8); PG8_BAR; PG8_WAIT_L(0); PG8_MMA(0, 0, At, B0); PG8_BAR; PG8_SCHED;
            PG8_LDB(B1, 0, 1); PG8_STAGE(PG8_SB(0, 0), b2, voffB);
            PG8_BAR; PG8_WAIT_L(0); PG8_MMA(0, 1, At, B1); PG8_BAR;
            PG8_LDA(At, 0, 1); PG8_STAGE(PG8_SA(0, 0), a2, voffA);
            PG8_BAR; PG8_WAIT_L(0); PG8_MMA(1, 0, At, B0); PG8_BAR; PG8_SCHED;
            PG8_STAGE(PG8_SB(0, 1), b2 + hstep, voffB);
            PG8_WAIT_V(6); PG8_BAR; PG8_MMA(1, 1, At, B1); PG8_BAR;
            PG8_LDB(B0, 1, 0); PG8_SCHED; PG8_LDA(At, 1, 0); PG8_STAGE(PG8_SA(0, 1), a2 + hstep, voffA);
            PG8_WAIT_L(8); PG8_BAR; PG8_WAIT_L(0); PG8_MMA(0, 0, At, B0); PG8_BAR; PG8_SCHED;
            PG8_LDB(B1, 1, 1); PG8_STAGE(PG8_SB(1, 0), b3, voffB);
            PG8_BAR; PG8_WAIT_L(0); PG8_MMA(0, 1, At, B1); PG8_BAR;
            PG8_LDA(At, 1, 1); PG8_STAGE(PG8_SA(1, 0), a3, voffA);
            PG8_BAR; PG8_WAIT_L(0); PG8_MMA(1, 0, At, B0); PG8_BAR; PG8_SCHED;
            PG8_STAGE(PG8_SB(1, 1), b3 + hstep, voffB);
            PG8_WAIT_V(6); PG8_BAR; PG8_MMA(1, 1, At, B1); PG8_BAR;
            }
        }
        if constexpr (ALIGN_EPI) { if (wr == 0) PG8_BAR; }
        { const int l2 = fresh_lane(); E(acc, cur, wr, wc, l2 & 15, l2 >> 4, wid, l2, ui & 1); } S.done(cur);
        if (!has_next) break;
#pragma unroll
        for (int a = 0; a < 2; ++a)
#pragma unroll
            for (int b = 0; b < 2; ++b)
#pragma unroll
                for (int m = 0; m < 4; ++m)
#pragma unroll
                    for (int n = 0; n < 2; ++n) acc[a][b][m][n] = (f32x4){0.f, 0.f, 0.f, 0.f};
        cur = nxt; cA = nA; cB = nB; ++ui;
        if constexpr (ALIGN_EPI) { if (wr == 1) PG8_BAR; }
        { const int l3 = fresh_lane(); E.prepare(cur, wid, l3, ui & 1); }
    }
    PG8_WAIT_V(0);
    if constexpr (!ALIGN_EPI) { if (wr == 0) PG8_BAR; }
    PG8_BAR;
#undef PG8_SA
#undef PG8_SB
#undef PG8_STAGE
#undef PG8_LDA
#undef PG8_LDB
#undef PG8_MMA
#undef PG8_WAIT_V
#undef PG8_WAIT_L
#undef PG8_BAR
#undef PG8_SCHED
}
}

#ifndef PG8_SP2
#define PG8_SP2 true
#endif
#ifndef PG8_ALIGN
#define PG8_ALIGN true
#endif

constexpr int NWAVES = 8;
constexpr int M = 16384, D = 2048, DEPTH = 4, FF = 8192, INW = 7184, ZW = 7168, PLE = 256;
constexpr int HGW = 1024, HGH = 8, HD = 128;
constexpr int GH = 4, GDK = 128, GDV = 256, GKW = 512, GLAW = 1024, GRANK = 16;
constexpr int ZC_HQ = 0, ZC_HF = 1024, ZC_HI = 2048, ZC_HG = 3072, ZC_GQ = 4096, ZC_GK = 4608, ZC_GV = 5120, ZC_GR = 6144;
constexpr int CONVC = 2048;
constexpr float EPS = 1e-6f;
constexpr int CHUNK = 64, NCHUNK = M / CHUNK;

constexpr size_t MiB = 1u << 20;
constexpr size_t WS_CTL = 0, CTL_ZERO_BYTES = 1 * MiB;
constexpr size_t WS_STATS = 1 * MiB;
constexpr size_t STATS_BYTES = (size_t)M * 32 * 4;
constexpr size_t WS_GA = 7 * MiB;
constexpr size_t WS_DEC = 8 * MiB;
constexpr size_t WS_PB = 12 * MiB;
constexpr size_t WS_HBA = 20 * MiB, WS_HBB = 84 * MiB;
constexpr size_t WS_W = 148 * MiB, W_LAYER = 110 * MiB;
constexpr size_t WO_IN = 0, WO_OUT = 28 * MiB, WO_UP = 36 * MiB, WO_DN = 68 * MiB, WO_PG = 100 * MiB, WO_PP = 108 * MiB, WO_GA = 109 * MiB;
constexpr size_t WS_UNION = 588 * MiB;
constexpr size_t UO_Z = 0, UO_OBUF = 224 * MiB, UO_S = 224 * MiB, UO_SSUP = 352 * MiB, UO_A = 0, UO_PP = 256 * MiB, UO_H8 = 320 * MiB  ;
constexpr size_t WS_END = 972 * MiB;

constexpr int CW_BAR = 4096;

constexpr int RING_OFF = 0, RING_BYTES = 131072;
constexpr int LDS_BYTES = 163840;
constexpr int RTAB_OFF = RING_BYTES;
constexpr int LDSCTL_BYTES = 1024, LDSCTL_OFF = LDS_BYTES - LDSCTL_BYTES, MISC_OFF = LDSCTL_OFF + 320;

#define GAS __attribute__((address_space(1)))
#define LAS __attribute__((address_space(3)))
typedef unsigned short bf16;
typedef unsigned v4u __attribute__((ext_vector_type(4)));
typedef unsigned v2u __attribute__((ext_vector_type(2)));
typedef float f32x4 __attribute__((ext_vector_type(4)));
typedef GAS unsigned gu32;
#define LDS_WAIT() asm volatile("s_waitcnt lgkmcnt(0)" ::: "memory")
#define VM_WAIT() asm volatile("s_waitcnt vmcnt(0)" ::: "memory")
__device__ __forceinline__ unsigned f2bf(float f) { unsigned u = __builtin_bit_cast(unsigned, f); return (u + 0x7fffu + ((u >> 16) & 1u)) >> 16; }
__device__ __forceinline__ unsigned pk2(float lo, float hi) { return f2bf(lo) | (f2bf(hi) << 16); }
__device__ __forceinline__ float bf2f(bf16 b) { return __uint_as_float(((unsigned)b) << 16); }

#define XB_TMO      128
#define XB_XCNT(j)  (256  + 64 * (j))
#define XB_XSUB(j)  (1280 + 64 * (j))
#define XB_XGEN(j)  (2304 + 64 * (j))
#define XB_TOP      3328
#define XB_TOPGEN   3392
#define XCD_BAR_WORDS 3456
#define XB_SPIN_CAP (1u << 20)
__device__ __forceinline__ unsigned xb_ld(unsigned* p)              { return __hip_atomic_load(p, __ATOMIC_RELAXED, __HIP_MEMORY_SCOPE_AGENT); }
__device__ __forceinline__ unsigned xb_add(unsigned* p, unsigned v) { return __hip_atomic_fetch_add(p, v, __ATOMIC_RELAXED, __HIP_MEMORY_SCOPE_AGENT); }
__device__ __forceinline__ unsigned xb_xcc_id() { return (unsigned)__builtin_amdgcn_s_getreg((3 << 11) | 20) & 0xFu; }
#define XB_SPIN(cond, bar) do { unsigned _sp = 0; while (cond) { __builtin_amdgcn_s_sleep(1); \
    if ((++_sp & 255u) == 0u) { if (xb_ld(&(bar)[XB_TMO])) break; if (_sp > XB_SPIN_CAP) { atomicAdd(&(bar)[XB_TMO], 1u); break; } } } } while (0)
struct XcdBarrier { unsigned* bar; unsigned x; volatile LAS unsigned* st; };
__device__ __forceinline__ XcdBarrier xcd_barrier_post(unsigned* bar, volatile LAS unsigned* st) {
    XcdBarrier b; b.bar = bar; b.x = xb_xcc_id(); b.st = st;
    if (threadIdx.x == 0) (void)xb_add(&bar[XB_XCNT(b.x)], 1u);
    return b;
}
__device__ __forceinline__ void xcd_barrier_complete(unsigned* bar, unsigned x, unsigned& nloc, unsigned& nx) {
    const unsigned G = gridDim.x * gridDim.y * gridDim.z;
    unsigned sum, cnt, mine, sp = 0u;
    for (;;) {
        sum = 0u; cnt = 0u; mine = 0u;
#pragma unroll 1
        for (unsigned j = 0; j < 16; ++j) { const unsigned c = xb_ld(&bar[XB_XCNT(j)]); sum += c; cnt += (c > 0u) ? 1u : 0u; mine = (j == x) ? c : mine; }
        if (sum == G) break;
        __builtin_amdgcn_s_sleep(1);
        if ((++sp & 255u) == 0u) { if (xb_ld(&bar[XB_TMO])) break; if (sp > XB_SPIN_CAP) { atomicAdd(&bar[XB_TMO], 1u); break; } }
    }
    nloc = mine > 0u ? mine : 1u; nx = cnt > 0u ? cnt : 1u;
}
__device__ __forceinline__ void xcd_barrier(const XcdBarrier& b, unsigned* barw_in) {
    asm volatile("s_waitcnt vmcnt(0)" ::: "memory");
    __syncthreads();
    if (threadIdx.x == 0) {
        unsigned* bar = barw_in; asm volatile("" : "+s"(bar));
        __builtin_amdgcn_s_waitcnt(0);
        unsigned nloc = b.st[0], nx = b.st[1];
        if (nloc == 0u) { xcd_barrier_complete(bar, b.x, nloc, nx); b.st[0] = nloc; b.st[1] = nx; }
        const unsigned old = xb_add(&bar[XB_XSUB(b.x)], 1u);
        const unsigned gen = old / nloc;
        if (old + 1u == (gen + 1u) * nloc) {
            __builtin_amdgcn_fence(__ATOMIC_RELEASE, "agent");
            asm volatile("s_waitcnt vmcnt(0)" ::: "memory");
            const unsigned og = xb_add(&bar[XB_TOP], 1u);
            const unsigned tg = og / nx;
            if (og + 1u == (tg + 1u) * nx) xb_add(&bar[XB_TOPGEN], 1u);
            else XB_SPIN(xb_ld(&bar[XB_TOPGEN]) == tg, bar);
            __builtin_amdgcn_fence(__ATOMIC_ACQUIRE, "agent");
            xb_add(&bar[XB_XGEN(b.x)], 1u);
            asm volatile("s_waitcnt vmcnt(0)" ::: "memory");
        } else {
            XB_SPIN(xb_ld(&bar[XB_XGEN(b.x)]) == gen, bar);
            __builtin_amdgcn_fence(__ATOMIC_ACQUIRE, "agent");
            asm volatile("s_waitcnt vmcnt(0)" ::: "memory");
        }
    }
    __syncthreads();
}

struct Args {
    const float *x, *p, *g_mix, *w_in, *lb_logits, *g_hg, *conv_w, *w_gate, *b_gate, *g_gla, *w_out, *g_mlp, *w_up, *w_down, *g_ple, *w_pg, *w_pp, *g_final;
    float* out; unsigned char* ws; int ph_lo, ph_hi;
};
struct Frame {
    LAS unsigned char* lds;
    int tid, lane, wave, G, gw, NGW;
};
__device__ __forceinline__ float wave_sum(float v) {
    v += pg8::dpp_get<0xB1>(v); v += pg8::dpp_get<0x4E>(v); v += pg8::dpp_get<0x141>(v); v += pg8::dpp_get<0x140>(v);
    return pg8::sum_xor32(pg8::sum_xor16(v));
}
__device__ __forceinline__ float sigmoidf_(float x) { return __builtin_amdgcn_rcpf(1.0f + __builtin_amdgcn_exp2f(x * -1.4426950408889634f)); }
__device__ __forceinline__ float siluf_(float x) { return x * __builtin_amdgcn_rcpf(1.0f + __builtin_amdgcn_exp2f(x * -1.4426950408889634f)); }

template <bool F8 = false, bool TILED = true>
__device__ __forceinline__ void transpose_item(const float* W, int ldw, int k0, int n0, int ncols, bf16* WT, int K, int nrow0, const float* g, LAS float* scr, int lane) {
    const int r4 = lane >> 4, c4 = lane & 15;
    f32x4 v[16];
#pragma unroll
    for (int i = 0; i < 16; ++i) { const int row = 4 * i + r4; v[i] = (f32x4){0.f, 0.f, 0.f, 0.f}; if (c4 * 4 < ncols) v[i] = *(const f32x4*)(W + (size_t)(k0 + row) * ldw + n0 + c4 * 4); }
#pragma unroll
    for (int i = 0; i < 16; ++i) { const int row = 4 * i + r4; const float gs = (g ? g[k0 + row] : 1.0f) * (F8 ? pg8::F8_WSCALE : 1.0f);
        *(LAS f32x4*)(scr + row * 68 + ((c4 * 4) ^ ((row >> 3) << 2))) = v[i] * gs; }
    LDS_WAIT(); asm volatile("" ::: "memory");
    if constexpr (TILED) {
        const int r = lane >> 2, kp = lane & 3;
#pragma unroll
        for (int j = 0; j < 8; ++j) { const int blk = j >> 2, gq = (j >> 1) & 1, ksub = j & 1, k8 = ksub * 4 + kp, n = blk * 32 + pg8::perm32(16 * gq + r), q = nrow0 + blk * 32 + 16 * gq + r;
            const LAS float* s = scr + (8 * k8) * 68 + (n ^ (k8 << 2));
            if constexpr (F8) {
                v2u o8; o8.x = pg8::cvt_pk_fp8x4(s[0 * 68], s[1 * 68], s[2 * 68], s[3 * 68]); o8.y = pg8::cvt_pk_fp8x4(s[4 * 68], s[5 * 68], s[6 * 68], s[7 * 68]);
                *(GAS v2u*)((unsigned char*)WT + (((size_t)(q >> 4) * (K >> 6) + (k0 >> 6)) << 10) + (q & 15) * 64 + 8 * k8) = o8;
            } else {
                v4u o; o.x = pg8::cvt_pk_bf16(s[0 * 68], s[1 * 68]); o.y = pg8::cvt_pk_bf16(s[2 * 68], s[3 * 68]); o.z = pg8::cvt_pk_bf16(s[4 * 68], s[5 * 68]); o.w = pg8::cvt_pk_bf16(s[6 * 68], s[7 * 68]);
                *(GAS v4u*)(WT + (((size_t)(q >> 4) * (K >> 5) + (k0 >> 5) + ksub) << 9) + (q & 15) * 32 + 8 * kp) = o; } }
    } else {
    const int c = lane & 7;
    #pragma unroll
        for (int j = 0; j < 8; ++j) { const int n = (lane >> 3) + 8 * j; const LAS float* s = scr + (8 * c) * 68 + (n ^ (c << 2));
            if constexpr (F8) {
                v2u o8; o8.x = pg8::cvt_pk_fp8x4(s[0 * 68], s[1 * 68], s[2 * 68], s[3 * 68]); o8.y = pg8::cvt_pk_fp8x4(s[4 * 68], s[5 * 68], s[6 * 68], s[7 * 68]);
                if (n < ncols) *(GAS v2u*)((unsigned char*)WT + (size_t)(nrow0 + n) * K + k0 + 8 * c) = o8; continue; }
            v4u o; o.x = pg8::cvt_pk_bf16(s[0 * 68], s[1 * 68]); o.y = pg8::cvt_pk_bf16(s[2 * 68], s[3 * 68]); o.z = pg8::cvt_pk_bf16(s[4 * 68], s[5 * 68]); o.w = pg8::cvt_pk_bf16(s[6 * 68], s[7 * 68]);
            if (n < ncols) *(GAS v4u*)(WT + (size_t)(nrow0 + n) * K + k0 + 8 * c) = o; }
}
    LDS_WAIT(); asm volatile("" ::: "memory");
}

__device__ __forceinline__ void prologue(const Args& a, Frame& F) {
    LAS float* scr = (LAS float*)(F.lds + RING_OFF + F.wave * 17408);
    constexpr int I_IN = 32 * 112, I_GA = 32, I_OUT = 32 * 32, I_UP = 32 * 128, I_DN = 128 * 32, I_PG = 32 * 32, I_PP = 4 * 32;
    constexpr int I_LAYER = I_IN + I_GA + I_OUT + I_UP + I_DN + I_PG + I_PP;
    for (int it = F.gw; it < DEPTH * I_LAYER; it += F.NGW) {
        const int l = it / I_LAYER; int r = it % I_LAYER;
        unsigned char* wl = a.ws + WS_W + (size_t)l * W_LAYER;
        if (r < I_IN) { const int kb = r / 112, nb = r % 112; transpose_item(a.w_in + (size_t)l * D * INW, INW, 64 * kb, 64 * nb, 64, (bf16*)(wl + WO_IN), D, 64 * nb, a.g_mix + l * D, scr, F.lane); continue; } r -= I_IN;
        if (r < I_GA) { transpose_item<false, false>(a.w_in + (size_t)l * D * INW, INW, 64 * r, ZW, 16, (bf16*)(wl + WO_GA), D, 0, a.g_mix + l * D, scr, F.lane); continue; } r -= I_GA;
        if (r < I_OUT) { const int kb = r / 32, nb = r % 32; transpose_item(a.w_out + (size_t)l * D * D, D, 64 * kb, 64 * nb, 64, (bf16*)(wl + WO_OUT), D, 64 * nb, nullptr, scr, F.lane); continue; } r -= I_OUT;
        if (r < I_UP) { const int kb = r / 128, nb = r % 128; transpose_item(a.w_up + (size_t)l * D * FF, FF, 64 * kb, 64 * nb, 64, (bf16*)(wl + WO_UP), D, 64 * nb, a.g_mlp + l * D, scr, F.lane); continue; } r -= I_UP;
        if (r < I_DN) { const int kb = r / 32, nb = r % 32; transpose_item(a.w_down + (size_t)l * FF * D, D, 64 * kb, 64 * nb, 64, (bf16*)(wl + WO_DN), FF, 64 * nb, nullptr, scr, F.lane); continue; } r -= I_DN;
        if (r < I_PG) { const int kb = r / 32, nb = r % 32; transpose_item<true>(a.w_pg + (size_t)l * D * D, D, 64 * kb, 64 * nb, 64, (bf16*)(wl + WO_PG), D, 64 * nb, a.g_ple + l * D, scr, F.lane); continue; } r -= I_PG;
        { const int kb = r / 32, nb = r % 32; transpose_item(a.w_pp + (size_t)l * PLE * D, D, 64 * kb, 64 * nb, 64, (bf16*)(wl + WO_PP), PLE, 64 * nb, nullptr, scr, F.lane); }
    }
    bf16* hb = (bf16*)(a.ws + WS_HBA); float* st = (float*)(a.ws + WS_STATS);
    LAS unsigned char* xb = F.lds + RING_OFF;
    __syncthreads();
    for (int g = blockIdx.x; g < M / 16; g += F.G) {
        f32x4 v[2][8];
#pragma unroll
        for (int r = 0; r < 2; ++r) { const GAS f32x4* xr = (const GAS f32x4*)(a.x + (size_t)(g * 16 + 2 * F.wave + r) * D) + F.lane;
#pragma unroll
            for (int j = 0; j < 8; ++j) v[r][j] = xr[64 * j]; }
#pragma unroll
        for (int r = 0; r < 2; ++r) { const int lr = 2 * F.wave + r, m = g * 16 + lr; float s = 0.f;
#pragma unroll
            for (int j = 0; j < 8; ++j) { const f32x4 q = v[r][j]; s += (q.x * q.x + q.y * q.y) + (q.z * q.z + q.w * q.w); v2u w; w.x = pg8::cvt_pk_bf16(q.x, q.y); w.y = pg8::cvt_pk_bf16(q.z, q.w);
                *(LAS v2u*)(xb + lr * 4160 + (F.lane + 64 * j) * 8) = w; }
            s = wave_sum(s);
            if (F.lane < 32) st[(size_t)m * 32 + F.lane] = (F.lane == 0) ? s : 0.f; }
        __syncthreads();
#pragma unroll
        for (int k = 0; k < 8; ++k) { const int sub = F.wave * 8 + k;
            const v4u w = *(const LAS v4u*)(xb + (F.lane >> 2) * 4160 + (sub * 32 + (F.lane & 3) * 8) * 2);
            *(GAS v4u*)(hb + (((size_t)g * (D >> 5) + sub) << 9) + F.lane * 8) = w; }
        __syncthreads();
    }
}

__device__ __forceinline__ void ga_phase(const Args& a, Frame& F, const bf16* hb, const bf16* wga, const float* stats, float* GA) {
    typedef short bf16x8g __attribute__((ext_vector_type(8)));
    const int fr = F.lane & 15, fq = F.lane >> 4, tl = F.wave & 3, kh = F.wave >> 2;
    LAS f32x4* part = (LAS f32x4*)(F.lds);
    for (int t = blockIdx.x * 4 + tl; t < M / 16; t += F.G * 4) {
        const int row0 = t * 16;
        const bf16* ap = hb + pg8::tile_rc(row0 + fr, kh * (D / 2) + fq * 8, D);
        const bf16* bp = wga + (size_t)fr * D + kh * (D / 2) + fq * 8;
        f32x4 acc = {0.f, 0.f, 0.f, 0.f};
#pragma unroll 8
        for (int kk = 0; kk < D / 64; ++kk) {
            const bf16x8g av = *(const bf16x8g*)(ap + kk * 512), bv = *(const bf16x8g*)(bp + kk * 32);
            acc = __builtin_amdgcn_mfma_f32_16x16x32_bf16(av, bv, acc, 0, 0, 0); }
        if (kh == 1) part[tl * 64 + F.lane] = acc;
        __syncthreads();
        if (kh == 0) {
            acc = acc + part[tl * 64 + F.lane];
            const f32x4* sp = (const f32x4*)(stats + (size_t)(row0 + fr) * 32 + fq * 8); const f32x4 s0 = sp[0], s1 = sp[1];
            float sv = ((s0[0] + s0[1]) + (s0[2] + s0[3])) + ((s1[0] + s1[1]) + (s1[2] + s1[3]));
            sv = pg8::sum_xor16(sv); sv = pg8::sum_xor32(sv);
            const float rstd = __builtin_amdgcn_rsqf(sv * (1.0f / D) + EPS);
#pragma unroll
            for (int i = 0; i < 4; ++i) GA[(size_t)(row0 + 4 * fq + i) * GRANK + fr] = acc[i] * __builtin_bit_cast(float, __builtin_amdgcn_ds_bpermute((4 * fq + i) * 4, __builtin_bit_cast(int, rstd)));
        }
        __syncthreads();
    }
}

__device__ __forceinline__ void pb_phase(const Args& a, Frame& F, int l) {
    const GAS f32x4* src = (const GAS f32x4*)(a.p + (size_t)l * M * PLE); GAS v2u* dst = (GAS v2u*)(a.ws + WS_PB);
    const size_t n4 = (size_t)M * PLE / 4;
    const size_t stride = (size_t)F.G * 512;
    for (size_t i0 = (size_t)blockIdx.x * 512 + F.tid; i0 < n4; i0 += 8 * stride) {
        f32x4 v[8];
#pragma unroll
        for (int j = 0; j < 8; ++j) { const size_t i = i0 + j * stride; v[j] = (i < n4) ? src[i] : (f32x4){0.f, 0.f, 0.f, 0.f}; }
#pragma unroll
        for (int j = 0; j < 8; ++j) { const size_t i = i0 + j * stride; if (i < n4) { v2u w; w.x = pg8::cvt_pk_bf16(v[j].x, v[j].y); w.y = pg8::cvt_pk_bf16(v[j].z, v[j].w); dst[i] = w; } }
    }
}

namespace mx {
typedef short bf16x8 __attribute__((ext_vector_type(8)));
typedef float f32x2v __attribute__((ext_vector_type(2)));
constexpr int AR = 0;
constexpr int RS128 = 272, RS256 = 528, TS = 144;
constexpr int RW128 = 256, RW256 = 512;
constexpr int A_RAWQ = 0, A_RAWK = 17408, A_RAWV = 34816;
constexpr int A_GAT = 69632;
constexpr int A_QT = 73728, A_KT = 91136, A_KDT = A_QT, A_VT = 108544, A_P = 145408;
constexpr int A_TOT = 154624, A_RED = 156672, A_DV = 158720, A_EMV = 159232, A_END = 159744;
constexpr int A_YST = A_QT;
static_assert(AR + A_END <= LDSCTL_OFF, "mixer arena vs LDS control words");
constexpr int E_TOTAL = 8 * 128 * 128 + 4 * 256 * 128;
constexpr int SUPER = 4, NSUPER = NCHUNK / SUPER;
constexpr float XCL = 100.0f;

template <int DV> __device__ __forceinline__ size_t st_off(int v, int k4, int fq) { return ((size_t)((2 * k4 + (fq >> 1)) * DV + v) << 4) + 8 * (fq & 1); }
__device__ __forceinline__ float clampx(float x) { return fminf(fmaxf(x, -XCL), XCL); }
__device__ __forceinline__ void wg_sync() { asm volatile("s_waitcnt vmcnt(0) lgkmcnt(0)" ::: "memory"); __builtin_amdgcn_s_barrier(); asm volatile("" ::: "memory"); }
__device__ __forceinline__ void wg_sync_lds() { asm volatile("s_waitcnt lgkmcnt(0)" ::: "memory"); __builtin_amdgcn_s_barrier(); asm volatile("" ::: "memory"); }
__device__ __forceinline__ unsigned pk(float lo, float hi) { return pg8::cvt_pk_bf16(lo, hi); }

template <bool GLA, bool M3>
__device__ __forceinline__ void raw_issue(LAS unsigned char* ar, const int wave, const int lane, const bf16* Z, const float* GAg, const unsigned char* zero_page, const int t0, const int hu, const int buf) {
    const int oK = (!GLA && !M3 && buf) ? A_RAWQ : A_RAWK, oV = A_RAWV + ((!GLA && !M3 && buf) ? 17408 : 0);
#define MX_DMA(src, dstoff) __builtin_amdgcn_global_load_lds((const unsigned*)(src), (LAS unsigned*)(ar + (dstoff)), 16, 0, 0)
    if (!GLA) {
#pragma unroll
        for (int i = 0; i < 2; ++i) { const int pi = wave + 8 * i, row = 4 * pi + (lane >> 4), pc = lane & 15;
            const bf16* src = Z + pg8::tile_rc(t0 + row, hu * 128 + pc * 8, ZW);
            if (M3) MX_DMA(src + ZC_HQ * 16, A_RAWQ + pi * 1024);
            MX_DMA(src + ZC_HF * 16, oK + pi * 1024);
            MX_DMA(src + ZC_HI * 16, oV + pi * 1024); }
    } else {
#pragma unroll
        for (int i = 0; i < 3; ++i) { const int pi = wave + 8 * i;
            if (pi < 17) { int row = 4 * pi + (lane >> 4); row = row < 67 ? row : 66; const int pc = lane & 15, t = t0 - 3 + row;
                const unsigned char* base = (t < 0) ? (zero_page + pc * 16) : (const unsigned char*)(Z + pg8::tile_rc(t < 0 ? 0 : t, hu * 128 + pc * 8, ZW));
                const unsigned char* sq = (t < 0) ? base : base + ZC_GQ * 32; const unsigned char* sk = (t < 0) ? base : base + ZC_GK * 32;
                if (M3) MX_DMA(sq, A_RAWQ + pi * 1024);
                MX_DMA(sk, A_RAWK + pi * 1024); } }
#pragma unroll
        for (int i = 0; i < 5; ++i) { const int pi = wave + 8 * i;
            if (pi < 34) { int row = 2 * pi + (lane >> 5); row = row < 67 ? row : 66; const int pc = lane & 31, t = t0 - 3 + row;
                const unsigned char* sv = (t < 0) ? (zero_page + pc * 16) : (const unsigned char*)(Z + pg8::tile_rc(t < 0 ? 0 : t, ZC_GV + hu * 256 + pc * 8, ZW));
                MX_DMA(sv, A_RAWV + pi * 1024); } }
        if (wave < 4) MX_DMA(GAg + (size_t)t0 * GRANK + wave * 256 + lane * 4, A_GAT + wave * 1024);
    }
#undef MX_DMA
}

template <bool GLA, bool M3> struct Carry {
    static constexpr int DV = GLA ? 256 : 128, NVT = DV / 128;
    f32x4 acc[M3 ? 1 : DV / 16];
    v4u S[M3 ? NVT : 1][4];
    float dsum, lb;
};

template <bool GLA, bool M3>
__device__ __forceinline__ void mix_step(const Args& a, LAS unsigned char* ar, const int wave, const int lane, const int l, const int chunk, const int hu, const int j4,
                                         const bool has_next, const int nchunk, const int nhu,
                                         const bf16* Z, const float* GAg, const unsigned char* zero_page, bf16* SB, bf16* SSUP, float* DSUP, bf16* Y, Carry<GLA, M3>& C) {
    const int tid = wave * 64 + lane, t0 = chunk * CHUNK;
    constexpr int DV = GLA ? 256 : 128, NVT = DV / 128;
    const int c = tid & 127, seg = tid >> 7;
    const int fr = lane & 15, fq = lane >> 4;
    const int chq = GLA ? (1024 + hu * 128) : (hu * 128);
    const size_t eoff = GLA ? (131072 + hu * 32768) : (hu * 16384);
    const size_t sbase = (size_t)chunk * E_TOTAL + eoff, supbase = (size_t)(chunk / SUPER) * E_TOTAL + eoff;
    float ck0 = 0.f, ck1 = 0.f, ck2 = 0.f, ck3 = 0.f, cq0 = 0.f, cq1 = 0.f, cq2 = 0.f, cq3 = 0.f, bgv = 0.f, wg[GRANK];
    if (GLA) {
        const float* cwk = a.conv_w + (size_t)l * 4 * CONVC + 512 + hu * 128 + c; ck0 = cwk[0]; ck1 = cwk[CONVC]; ck2 = cwk[2 * CONVC]; ck3 = cwk[3 * CONVC];
        if (M3) { const float* cwq = a.conv_w + (size_t)l * 4 * CONVC + hu * 128 + c; cq0 = cwq[0]; cq1 = cwq[CONVC]; cq2 = cwq[2 * CONVC]; cq3 = cwq[3 * CONVC]; }
        const float* wgp = a.w_gate + (size_t)l * GRANK * GKW + hu * 128 + c; bgv = a.b_gate[(size_t)l * GKW + hu * 128 + c];
#pragma unroll
        for (int r = 0; r < GRANK; ++r) wg[r] = wgp[r * GKW];
    }
    wg_sync();
    constexpr bool DBUF = !GLA && !M3;
    const int oK = (DBUF && (j4 & 1)) ? A_RAWQ : A_RAWK, oV = A_RAWV + ((DBUF && (j4 & 1)) ? 17408 : 0);
    if (DBUF && has_next) raw_issue<GLA, M3>(ar, wave, lane, Z, GAg, zero_page, nchunk * CHUNK, nhu, (j4 + 1) & 1);
    constexpr bool HOIST = M3 && !GLA;
    v4u dsl[M3 ? NVT : 1][4]; v2u gate[M3 ? NVT : 1][4];
    const bf16* dsrc = (j4 < SUPER - 1) ? (SB + sbase) : (const bf16*)zero_page;
    const int gcol0 = GLA ? (ZC_GR + hu * 256) : (ZC_HG + hu * 128);
    if (HOIST) {
#pragma unroll
        for (int jv = 0; jv < NVT; ++jv) {
#pragma unroll
            for (int k4 = 0; k4 < 4; ++k4) dsl[jv][k4] = *(const v4u*)(dsrc + st_off<DV>((wave + 8 * jv) * 16 + fr, k4, fq));
#pragma unroll
            for (int tt = 0; tt < 4; ++tt) gate[jv][tt] = *(const v2u*)(Z + pg8::tile_rc(t0 + tt * 16 + fr, gcol0 + (wave + 8 * jv) * 16 + 4 * fq, ZW)); }
    }
    {
        const int sg = tid >> 7;
#pragma unroll
        for (int j = 0; j < NVT; ++j) { const int v = (tid & 127) + 128 * j; unsigned w[8];
            if (!GLA) {
#pragma unroll
                for (int i = 0; i < 8; ++i) { const unsigned lo = *(const LAS bf16*)(ar + oV + (sg * 16 + 2 * i) * RW128 + v * 2), hi = *(const LAS bf16*)(ar + oV + (sg * 16 + 2 * i + 1) * RW128 + v * 2); w[i] = lo | (hi << 16); }
            } else {
                const float* cw = a.conv_w + (size_t)l * 4 * CONVC + 1024 + hu * 256 + v; const float w0 = cw[0], w1 = cw[CONVC], w2 = cw[2 * CONVC], w3 = cw[3 * CONVC];
                float x0 = bf2f(*(const LAS bf16*)(ar + A_RAWV + (sg * 16 + 0) * RW256 + v * 2)), x1 = bf2f(*(const LAS bf16*)(ar + A_RAWV + (sg * 16 + 1) * RW256 + v * 2)), x2 = bf2f(*(const LAS bf16*)(ar + A_RAWV + (sg * 16 + 2) * RW256 + v * 2));
                float o[16];
#pragma unroll
                for (int i = 0; i < 16; ++i) { const float x3 = bf2f(*(const LAS bf16*)(ar + A_RAWV + (sg * 16 + i + 3) * RW256 + v * 2)); o[i] = siluf_(w0 * x0 + w1 * x1 + w2 * x2 + w3 * x3); x0 = x1; x1 = x2; x2 = x3; }
#pragma unroll
                for (int i = 0; i < 8; ++i) w[i] = pk(o[2 * i], o[2 * i + 1]);
            }
            v4u wa = {w[0], w[1], w[2], w[3]}, wb = {w[4], w[5], w[6], w[7]};
            *(LAS v4u*)(ar + A_VT + v * TS + sg * 32) = wa; *(LAS v4u*)(ar + A_VT + v * TS + sg * 32 + 16) = wb; }
    }
    {
        float lf[16], kk[16], qq[16];
        if (!GLA) {
            const float lb = C.lb;
#pragma unroll
            for (int i = 0; i < 16; ++i) { const int lt = seg * 16 + i; const float zf = bf2f(*(const LAS bf16*)(ar + oK + lt * RW128 + c * 2));
                const float en = __builtin_amdgcn_exp2f(zf * -1.4426950408889634f), sg = __builtin_amdgcn_rcpf(1.0f + en), f = lb + (1.0f - lb) * sg;
                lf[i] = __builtin_amdgcn_logf(f); kk[i] = (1.0f - lb) * (en * sg);
                if (M3) qq[i] = bf2f(*(const LAS bf16*)(ar + A_RAWQ + lt * RW128 + c * 2)); }
        } else {
            float xk0 = bf2f(*(const LAS bf16*)(ar + A_RAWK + (seg * 16 + 0) * RW128 + c * 2)), xk1 = bf2f(*(const LAS bf16*)(ar + A_RAWK + (seg * 16 + 1) * RW128 + c * 2)), xk2 = bf2f(*(const LAS bf16*)(ar + A_RAWK + (seg * 16 + 2) * RW128 + c * 2));
            float xq0 = 0.f, xq1 = 0.f, xq2 = 0.f;
            if (M3) { xq0 = bf2f(*(const LAS bf16*)(ar + A_RAWQ + (seg * 16 + 0) * RW128 + c * 2)); xq1 = bf2f(*(const LAS bf16*)(ar + A_RAWQ + (seg * 16 + 1) * RW128 + c * 2)); xq2 = bf2f(*(const LAS bf16*)(ar + A_RAWQ + (seg * 16 + 2) * RW128 + c * 2)); }
#pragma unroll
            for (int i = 0; i < 16; ++i) { const int lt = seg * 16 + i;
                const float xk3 = bf2f(*(const LAS bf16*)(ar + A_RAWK + (lt + 3) * RW128 + c * 2)); kk[i] = siluf_(ck0 * xk0 + ck1 * xk1 + ck2 * xk2 + ck3 * xk3); xk0 = xk1; xk1 = xk2; xk2 = xk3;
                if (M3) { const float xq3 = bf2f(*(const LAS bf16*)(ar + A_RAWQ + (lt + 3) * RW128 + c * 2)); qq[i] = siluf_(cq0 * xq0 + cq1 * xq1 + cq2 * xq2 + cq3 * xq3) * 0.08838834764831845f; xq0 = xq1; xq1 = xq2; xq2 = xq3; }
                float xg = bgv; const LAS f32x4* gr = (const LAS f32x4*)(ar + A_GAT + lt * 64);
#pragma unroll
                for (int r4 = 0; r4 < 4; ++r4) { const f32x4 gv = gr[r4]; xg += gv[0] * wg[4 * r4] + gv[1] * wg[4 * r4 + 1] + gv[2] * wg[4 * r4 + 2] + gv[3] * wg[4 * r4 + 3]; }
                lf[i] = (fminf(xg, 0.f) * 1.4426950408889634f - __builtin_amdgcn_logf(1.0f + __builtin_amdgcn_exp2f(fabsf(xg) * -1.4426950408889634f))) * (1.0f / 16.0f); }
        }
#pragma unroll
        for (int i = 1; i < 16; ++i) lf[i] += lf[i - 1];
        ((LAS float*)(ar + A_TOT))[seg * 128 + c] = lf[15];
        wg_sync_lds();
        if (!DBUF && has_next) raw_issue<GLA, M3>(ar, wave, lane, Z, GAg, zero_page, nchunk * CHUNK, nhu, 0);
        const float t0s = ((const LAS float*)(ar + A_TOT))[c], t1s = ((const LAS float*)(ar + A_TOT))[128 + c], t2s = ((const LAS float*)(ar + A_TOT))[256 + c], t3s = ((const LAS float*)(ar + A_TOT))[384 + c];
        const float mref = t0s + t1s, blast = (t0s + t1s) + (t2s + t3s);
        const float off = (seg == 0) ? 0.f : (seg == 1) ? t0s : (seg == 2) ? (t0s + t1s) : ((t0s + t1s) + t2s);
        if (seg == 0) { ((LAS float*)(ar + A_DV))[c] = __builtin_amdgcn_exp2f(blast); if (M3) ((LAS float*)(ar + A_EMV))[c] = __builtin_amdgcn_exp2f(mref); }
        if (M3) {
#pragma unroll
            for (int i = 0; i < 16; ++i) { const int lt = seg * 16 + i; const float b = off + lf[i];
                const unsigned qk = pk(qq[i] * __builtin_amdgcn_exp2f(fminf(b - mref, XCL)), kk[i] * __builtin_amdgcn_exp2f(fminf(mref - b, XCL)));
                *(LAS bf16*)(ar + A_QT + lt * RS128 + c * 2) = (bf16)(qk & 0xffffu);
                *(LAS bf16*)(ar + A_KT + lt * RS128 + c * 2) = (bf16)(qk >> 16); }
        } else {
            unsigned w[8];
#pragma unroll
            for (int i = 0; i < 8; ++i) { const float b0 = off + lf[2 * i], b1 = off + lf[2 * i + 1]; w[i] = pk(kk[2 * i] * __builtin_amdgcn_exp2f(blast - b0), kk[2 * i + 1] * __builtin_amdgcn_exp2f(blast - b1)); }
            v4u wa = {w[0], w[1], w[2], w[3]}, wb = {w[4], w[5], w[6], w[7]};
            *(LAS v4u*)(ar + A_KDT + c * TS + seg * 32) = wa; *(LAS v4u*)(ar + A_KDT + c * TS + seg * 32 + 16) = wb;
            if (seg == 0) { C.dsum += blast; if (j4 == SUPER - 1) DSUP[(size_t)(chunk / SUPER) * 1536 + chq + c] = __builtin_amdgcn_exp2f(C.dsum); }
        }
    }
    wg_sync_lds();
    if (!M3) {
        const bf16x8 a0 = *(const LAS bf16x8*)(ar + A_KDT + (wave * 16 + fr) * TS + fq * 16), a1 = *(const LAS bf16x8*)(ar + A_KDT + (wave * 16 + fr) * TS + fq * 16 + 64);
        const f32x4 dv = *(const LAS f32x4*)(ar + A_DV + (wave * 16 + 4 * fq) * 4);
        const size_t orow = ((size_t)(wave * DV + (fq & 1) * 16 + fr) << 4) + 4 * (fq & ~1);
#pragma unroll
        for (int vt = 0; vt < DV / 16; vt += 2) {
            f32x4 t2[2];
#pragma unroll
            for (int h = 0; h < 2; ++h) {
                const bf16x8 b0 = *(const LAS bf16x8*)(ar + A_VT + ((vt + h) * 16 + fr) * TS + fq * 16), b1 = *(const LAS bf16x8*)(ar + A_VT + ((vt + h) * 16 + fr) * TS + fq * 16 + 64);
                f32x4 t = {0.f, 0.f, 0.f, 0.f};
                t = __builtin_amdgcn_mfma_f32_16x16x32_bf16(a0, b0, t, 0, 0, 0);
                t = __builtin_amdgcn_mfma_f32_16x16x32_bf16(a1, b1, t, 0, 0, 0);
                t2[h] = t; }
            if (j4 < SUPER - 1) {
                const auto r0 = __builtin_amdgcn_permlane16_swap(pk(t2[0][0], t2[0][1]), pk(t2[1][0], t2[1][1]), false, false);
                const auto r1 = __builtin_amdgcn_permlane16_swap(pk(t2[0][2], t2[0][3]), pk(t2[1][2], t2[1][3]), false, false);
                v4u o; o.x = (unsigned)r0[0]; o.y = (unsigned)r1[0]; o.z = (unsigned)r0[1]; o.w = (unsigned)r1[1];
                *(v4u*)(SB + sbase + (size_t)vt * 16 * 16 + orow) = o; }
            C.acc[vt] = C.acc[vt] * dv + t2[0]; C.acc[vt + 1] = C.acc[vt + 1] * dv + t2[1];
            if (j4 == SUPER - 1) {
                const auto r0 = __builtin_amdgcn_permlane16_swap(pk(C.acc[vt][0], C.acc[vt][1]), pk(C.acc[vt + 1][0], C.acc[vt + 1][1]), false, false);
                const auto r1 = __builtin_amdgcn_permlane16_swap(pk(C.acc[vt][2], C.acc[vt][3]), pk(C.acc[vt + 1][2], C.acc[vt + 1][3]), false, false);
                v4u o; o.x = (unsigned)r0[0]; o.y = (unsigned)r1[0]; o.z = (unsigned)r0[1]; o.w = (unsigned)r1[1];
                *(v4u*)(SSUP + supbase + (size_t)vt * 16 * 16 + orow) = o; } }
    } else {
        {
            const int tt = wave & 3;
#pragma unroll
            for (int j = 0; j < 2; ++j) { const int st = (wave >> 2) * 2 + j;
                f32x4 acc = {0.f, 0.f, 0.f, 0.f};
#pragma unroll
                for (int k4 = 0; k4 < 4; ++k4) { const bf16x8 ak = *(const LAS bf16x8*)(ar + A_KT + (st * 16 + fr) * RS128 + fq * 16 + k4 * 64), bq = *(const LAS bf16x8*)(ar + A_QT + (tt * 16 + fr) * RS128 + fq * 16 + k4 * 64);
                    acc = __builtin_amdgcn_mfma_f32_16x16x32_bf16(ak, bq, acc, 0, 0, 0); }
#pragma unroll
                for (int i = 0; i < 4; ++i) acc[i] = (st * 16 + 4 * fq + i <= tt * 16 + fr) ? acc[i] : 0.f;
                v2u o; o.x = pk(acc[0], acc[1]); o.y = pk(acc[2], acc[3]);
                *(LAS v2u*)(ar + A_P + (tt * 16 + fr) * TS + (st * 16 + 4 * fq) * 2) = o; }
        }
        if (!HOIST) {
#pragma unroll
            for (int jv = 0; jv < NVT; ++jv)
#pragma unroll
                for (int tt = 0; tt < 4; ++tt) gate[jv][tt] = *(const v2u*)(Z + pg8::tile_rc(t0 + tt * 16 + fr, gcol0 + (wave + 8 * jv) * 16 + 4 * fq, ZW));
        }
        wg_sync_lds();
        f32x4 oacc[NVT][4];
#pragma unroll
        for (int jv = 0; jv < NVT; ++jv) { const int vt = wave + 8 * jv;
            const bf16x8 va0 = *(const LAS bf16x8*)(ar + A_VT + (vt * 16 + fr) * TS + fq * 16), va1 = *(const LAS bf16x8*)(ar + A_VT + (vt * 16 + fr) * TS + fq * 16 + 64);
            bf16x8 sa[4];
            if (!HOIST) {
#pragma unroll
                for (int k4 = 0; k4 < 4; ++k4) dsl[jv][k4] = *(const v4u*)(dsrc + st_off<DV>(vt * 16 + fr, k4, fq));
            }
#pragma unroll
            for (int k4 = 0; k4 < 4; ++k4) { const f32x4 e0 = *(const LAS f32x4*)(ar + A_EMV + (k4 * 32 + fq * 8) * 4), e1 = *(const LAS f32x4*)(ar + A_EMV + (k4 * 32 + fq * 8 + 4) * 4);
                const v4u sp = C.S[jv][k4]; v4u w;
                w.x = pk(pg8::bf_lo(sp.x) * e0[0], pg8::bf_hi(sp.x) * e0[1]); w.y = pk(pg8::bf_lo(sp.y) * e0[2], pg8::bf_hi(sp.y) * e0[3]);
                w.z = pk(pg8::bf_lo(sp.z) * e1[0], pg8::bf_hi(sp.z) * e1[1]); w.w = pk(pg8::bf_lo(sp.w) * e1[2], pg8::bf_hi(sp.w) * e1[3]);
                sa[k4] = __builtin_bit_cast(bf16x8, w); }
#pragma unroll
            for (int tt = 0; tt < 4; ++tt) { f32x4 acc = {0.f, 0.f, 0.f, 0.f};
                const bf16x8 p0 = *(const LAS bf16x8*)(ar + A_P + (tt * 16 + fr) * TS + fq * 16);
                acc = __builtin_amdgcn_mfma_f32_16x16x32_bf16(va0, p0, acc, 0, 0, 0);
                if (tt >= 2) { const bf16x8 p1 = *(const LAS bf16x8*)(ar + A_P + (tt * 16 + fr) * TS + fq * 16 + 64); acc = __builtin_amdgcn_mfma_f32_16x16x32_bf16(va1, p1, acc, 0, 0, 0); }
#pragma unroll
                for (int k4 = 0; k4 < 4; ++k4) { const bf16x8 bq = *(const LAS bf16x8*)(ar + A_QT + (tt * 16 + fr) * RS128 + fq * 16 + k4 * 64); acc = __builtin_amdgcn_mfma_f32_16x16x32_bf16(sa[k4], bq, acc, 0, 0, 0); }
                oacc[jv][tt] = acc; }
            {
#pragma unroll
                for (int k4 = 0; k4 < 4; ++k4) { const f32x4 d0 = *(const LAS f32x4*)(ar + A_DV + (k4 * 32 + fq * 8) * 4), d1 = *(const LAS f32x4*)(ar + A_DV + (k4 * 32 + fq * 8 + 4) * 4);
                    const v4u sp = C.S[jv][k4], dl = dsl[jv][k4]; v4u w;
                    w.x = pk(pg8::bf_lo(sp.x) * d0[0] + pg8::bf_lo(dl.x), pg8::bf_hi(sp.x) * d0[1] + pg8::bf_hi(dl.x)); w.y = pk(pg8::bf_lo(sp.y) * d0[2] + pg8::bf_lo(dl.y), pg8::bf_hi(sp.y) * d0[3] + pg8::bf_hi(dl.y));
                    w.z = pk(pg8::bf_lo(sp.z) * d1[0] + pg8::bf_lo(dl.z), pg8::bf_hi(sp.z) * d1[1] + pg8::bf_hi(dl.z)); w.w = pk(pg8::bf_lo(sp.w) * d1[2] + pg8::bf_lo(dl.w), pg8::bf_hi(sp.w) * d1[3] + pg8::bf_hi(dl.w));
                    C.S[jv][k4] = w; }
            }
        }
#pragma unroll
        for (int tt = 0; tt < 4; ++tt) { float ss = 0.f;
#pragma unroll
            for (int jv = 0; jv < NVT; ++jv) ss += (oacc[jv][tt][0] * oacc[jv][tt][0] + oacc[jv][tt][1] * oacc[jv][tt][1]) + (oacc[jv][tt][2] * oacc[jv][tt][2] + oacc[jv][tt][3] * oacc[jv][tt][3]);
            ss = pg8::sum_xor16(ss); ss = pg8::sum_xor32(ss);
            if (fq == 0) ((LAS float*)(ar + A_RED))[(tt * 16 + fr) * 8 + wave] = ss; }
        wg_sync_lds();
        const float* gn = GLA ? (a.g_gla + (size_t)l * GLAW + hu * 256) : (a.g_hg + (size_t)l * HGW + hu * 128);
#pragma unroll
        for (int tt = 0; tt < 4; ++tt) { const int t = tt * 16 + fr;
            const f32x4 r0 = *(const LAS f32x4*)(ar + A_RED + t * 32), r1 = *(const LAS f32x4*)(ar + A_RED + t * 32 + 16);
            const float ms = (((r0[0] + r0[1]) + (r0[2] + r0[3])) + ((r1[0] + r1[1]) + (r1[2] + r1[3]))) * (1.0f / DV);
            const float rstd = __builtin_amdgcn_rsqf(ms + EPS);
#pragma unroll
            for (int jv = 0; jv < NVT; ++jv) { const int v = (wave + 8 * jv) * 16 + 4 * fq;
                const f32x4 g4 = *(const f32x4*)(gn + v); const v2u gw = gate[jv][tt];
                const float y0 = oacc[jv][tt][0] * rstd * g4[0] * siluf_(pg8::bf_lo(gw.x)), y1 = oacc[jv][tt][1] * rstd * g4[1] * siluf_(pg8::bf_hi(gw.x));
                const float y2 = oacc[jv][tt][2] * rstd * g4[2] * siluf_(pg8::bf_lo(gw.y)), y3 = oacc[jv][tt][3] * rstd * g4[3] * siluf_(pg8::bf_hi(gw.y));
                v2u o; o.x = pk(y0, y1); o.y = pk(y2, y3);
                *(LAS v2u*)(ar + A_YST + t * (GLA ? RS256 : RS128) + v * 2) = o; } }
        wg_sync_lds();
        {
            constexpr int PPR = DV / 8;
            const int ycol0 = GLA ? (1024 + hu * 256) : (hu * 128);
#pragma unroll
            for (int i = 0; i < (64 * PPR) / 512; ++i) { const int sidx = wave + 8 * i, rg = sidx / (DV / 32), scol = sidx % (DV / 32), r = rg * 16 + (lane >> 2), cc = scol * 32 + (lane & 3) * 8;
                *(v4u*)(Y + pg8::tile_rc(t0 + r, ycol0 + cc, 2048)) = *(const LAS v4u*)(ar + A_YST + r * (GLA ? RS256 : RS128) + cc * 2); }
        }
    }
}

template <bool GLA, bool M3>
__device__ __forceinline__ void mix_head(const Args& a, LAS unsigned char* ar, const int wave, const int l, const int sc, const int hu, const bf16* Z, const float* GAg, const unsigned char* zero_page, bf16* SB, bf16* SSUP, float* DSUP, bf16* Y) {
    constexpr int DV = GLA ? 256 : 128, NVT = DV / 128;
    Carry<GLA, M3> C; C.dsum = 0.f; C.lb = 0.f;
    {
        const int lane = pg8::fresh_lane(), tid = wave * 64 + lane, fr = lane & 15, fq = lane >> 4;
        raw_issue<GLA, M3>(ar, wave, lane, Z, GAg, zero_page, sc * SUPER * CHUNK, hu, 0);
        if (!GLA) { const int ch = hu * 128 + (tid & 127); float lg[DEPTH], mxv = -1e30f;
#pragma unroll
            for (int j = 0; j < DEPTH; ++j) { lg[j] = a.lb_logits[j * HGW + ch]; mxv = fmaxf(mxv, lg[j]); }
            float den = 0.f, num = 0.f;
#pragma unroll
            for (int j = 0; j < DEPTH; ++j) { const float e = __expf(lg[j] - mxv); den += e; if (j >= 1 && j <= l) num += e; }
            C.lb = num / den; }
        if (M3) {
            const size_t supbase = (size_t)sc * E_TOTAL + (GLA ? (131072 + hu * 32768) : (hu * 16384));
#pragma unroll
            for (int jv = 0; jv < NVT; ++jv)
#pragma unroll
                for (int k4 = 0; k4 < 4; ++k4) C.S[jv][k4] = *(const v4u*)(SSUP + supbase + st_off<DV>((wave + 8 * jv) * 16 + fr, k4, fq));
        } else {
#pragma unroll
            for (int vt = 0; vt < DV / 16; ++vt) C.acc[vt] = (f32x4){0.f, 0.f, 0.f, 0.f};
        }
    }
#pragma unroll 1
    for (int j = 0; j < SUPER; ++j) { const int lane = pg8::fresh_lane();
        mix_step<GLA, M3>(a, ar, wave, lane, l, sc * SUPER + j, hu, j, j + 1 < SUPER, sc * SUPER + j + 1, hu, Z, GAg, zero_page, SB, SSUP, DSUP, Y, C); }
    wg_sync();
}
template <bool M3>
__device__ __forceinline__ void mix_phase(const Args& a, LAS unsigned char* lds, const int wave, const int l, const bf16* Z, const float* GAg, bf16* SB, bf16* SSUP, float* DSUP, bf16* Y) {
    LAS unsigned char* ar = lds + AR;
    const unsigned char* zero_page = a.ws + WS_CTL + 512 * 1024;
    for (int w = blockIdx.x; w < NSUPER * 4; w += gridDim.x) {
        const int sc = w >> 2, s = w & 3;
#pragma unroll 1
        for (int k = 0; k < 3; ++k) { int which = k + (w % 3); which = which >= 3 ? which - 3 : which;
            if (which == 2) mix_head<true, M3>(a, ar, wave, l, sc, s, Z, GAg, zero_page, SB, SSUP, DSUP, Y);
            else mix_head<false, M3>(a, ar, wave, l, sc, 2 * s + which, Z, GAg, zero_page, SB, SSUP, DSUP, Y); }
    }
}

__device__ __forceinline__ void scan_phase(const int wave, bf16* SSUP, const float* DSUP) {
    const int lane = pg8::fresh_lane(), tid = wave * 64 + lane;
    for (int e2 = blockIdx.x * 512 + tid; e2 < E_TOTAL / 2; e2 += gridDim.x * 512) {
        const int e = e2 * 2; int ch;
        if (e < 131072) ch = (e >> 14) * 128 + (((e & 16383) >> 11) << 4) + (e & 15); else { const int e3 = e - 131072; ch = 1024 + (e3 >> 15) * 128 + (((e3 & 32767) >> 12) << 4) + (e3 & 15); }
        float S0 = 0.f, S1 = 0.f;
        constexpr int U = 16;
#pragma unroll 1
        for (int cb = 0; cb < NSUPER; cb += U) {
            unsigned d[U]; f32x2v dd[U];
#pragma unroll
            for (int u = 0; u < U; ++u) { d[u] = *(const unsigned*)(SSUP + (size_t)(cb + u) * E_TOTAL + e); dd[u] = *(const f32x2v*)(DSUP + (size_t)(cb + u) * 1536 + ch); }
#pragma unroll
            for (int u = 0; u < U; ++u) {
                *(unsigned*)(SSUP + (size_t)(cb + u) * E_TOTAL + e) = pk(S0, S1);
                S0 = dd[u][0] * S0 + pg8::bf_lo(d[u]); S1 = dd[u][1] * S1 + pg8::bf_hi(d[u]); }
        }
    }
}
}

template <int DV>
__device__ __forceinline__ void naive_scan_batch(const LAS float* q, const LAS float* f, const LAS float* k, const LAS float* v, float (&S)[128], float* obuf_col, int t0, int col) {
#pragma unroll 1
    for (int tt = 0; tt < 16; ++tt) {
        const float vv = v[tt * DV + col]; float o = 0.f;
#pragma unroll
        for (int c = 0; c < 128; c += 4) {
            const f32x4 ff = *(const LAS f32x4*)(f + tt * 128 + c), kk = *(const LAS f32x4*)(k + tt * 128 + c), qq = *(const LAS f32x4*)(q + tt * 128 + c);
#pragma unroll
            for (int j = 0; j < 4; ++j) { S[c + j] = ff[j] * S[c + j] + kk[j] * vv; o += qq[j] * S[c + j]; }
        }
        obuf_col[(size_t)(t0 + tt) * 2048] = o;
    }
}
__device__ __forceinline__ void naive_recurrence(const Args& a, Frame& F, int l, const bf16* Z, const float* GA, float* OBUF) {
    const int b = blockIdx.x; if (b >= 12) return;
    LAS float* q = (LAS float*)(F.lds); LAS float* f = q + 16 * 128; LAS float* k = f + 16 * 128; LAS float* v = k + 16 * 128;
    LAS float* lbv = v + 16 * 256;
    float S[128];
#pragma unroll
    for (int c = 0; c < 128; ++c) S[c] = 0.f;
    if (b < 8) {
        const int hh = b;
        if (F.tid < 128) { const int ch = hh * 128 + F.tid; float lg[DEPTH], mx = -1e30f;
#pragma unroll
            for (int j = 0; j < DEPTH; ++j) { lg[j] = a.lb_logits[j * HGW + ch]; mx = fmaxf(mx, lg[j]); }
            float den = 0.f, num = 0.f;
#pragma unroll
            for (int j = 0; j < DEPTH; ++j) { const float e = __expf(lg[j] - mx); den += e; if (j >= 1 && j <= l) num += e; }
            lbv[F.tid] = num / den; }
        __syncthreads();
        for (int t0 = 0; t0 < M; t0 += 16) {
#pragma unroll
            for (int i = 0; i < 4; ++i) { const int idx = F.tid + 512 * i, tt = idx >> 7, c = idx & 127; const bf16* zr = Z + (size_t)(t0 + tt) * ZW + hh * 128 + c;
                const float zq = bf2f(zr[ZC_HQ]), zf = bf2f(zr[ZC_HF]), zi = bf2f(zr[ZC_HI]); const float lb = lbv[c];
                const float ff = lb + (1.f - lb) * sigmoidf_(zf);
                q[idx] = zq; f[idx] = ff; k[idx] = 1.f - ff; v[idx] = zi; }
            __syncthreads();
            if (F.tid < 128) naive_scan_batch<128>(q, f, k, v, S, OBUF + hh * 128 + F.tid, t0, F.tid);
            __syncthreads();
        }
    } else {
        const int g = b - 8; const float* cw = a.conv_w + (size_t)l * 4 * CONVC; const float* wg = a.w_gate + (size_t)l * GRANK * GKW; const float* bg = a.b_gate + (size_t)l * GKW;
        for (int t0 = 0; t0 < M; t0 += 16) {
#pragma unroll 1
            for (int i = 0; i < 16; ++i) { const int idx = F.tid + 512 * i, tt = idx >> 9, cc = idx & 511;
                int ch; if (cc < 128) ch = g * 128 + cc; else if (cc < 256) ch = 512 + g * 128 + (cc - 128); else ch = 1024 + g * 256 + (cc - 256);
                const int t = t0 + tt; float s = 0.f;
#pragma unroll
                for (int j = 0; j < 4; ++j) { const int ts = t - 3 + j; if (ts >= 0) s += cw[j * CONVC + ch] * bf2f(Z[(size_t)ts * ZW + ZC_GQ + ch]); }
                s = siluf_(s);
                if (cc < 128) q[tt * 128 + cc] = s * 0.08838834764831845f; else if (cc < 256) k[tt * 128 + cc - 128] = s; else v[tt * 256 + cc - 256] = s; }
#pragma unroll
            for (int i = 0; i < 4; ++i) { const int idx = F.tid + 512 * i, tt = idx >> 7, c = idx & 127; float xg = bg[g * 128 + c];
#pragma unroll
                for (int r = 0; r < GRANK; ++r) xg += GA[(size_t)(t0 + tt) * GRANK + r] * wg[r * GKW + g * 128 + c];
                const float ls = fminf(xg, 0.f) - log1pf(__expf(-fabsf(xg)));
                f[idx] = __expf(ls * (1.0f / 16.0f)); }
            __syncthreads();
            if (F.tid < 256) naive_scan_batch<256>(q, f, k, v, S, OBUF + 1024 + g * 256 + F.tid, t0, F.tid);
            __syncthreads();
        }
    }
}
__device__ __forceinline__ void norm_gate_phase(const Args& a, Frame& F, int l, const bf16* Z, const float* OBUF, bf16* Y) {
    const float* ghg = a.g_hg + (size_t)l * HGW; const float* ggl = a.g_gla + (size_t)l * GLAW;
    for (int t = F.gw; t < M; t += F.NGW) {
        const float* orow = OBUF + (size_t)t * 2048; const bf16* zr = Z + (size_t)t * ZW; bf16* yr = Y + (size_t)t * 2048;
#pragma unroll 1
        for (int hh = 0; hh < HGH; ++hh) { const int c = hh * 128 + 2 * F.lane; const float o0 = orow[c], o1 = orow[c + 1];
            const float ms = wave_sum(o0 * o0 + o1 * o1) * (1.0f / 128.0f); const float r = __builtin_amdgcn_rsqf(ms + EPS);
            const float g0 = bf2f(zr[ZC_HG + c]), g1 = bf2f(zr[ZC_HG + c + 1]);
            *(unsigned*)(yr + c) = pk2(o0 * r * ghg[c] * siluf_(g0), o1 * r * ghg[c + 1] * siluf_(g1)); }
#pragma unroll 1
        for (int g = 0; g < GH; ++g) { const int c = g * 256 + 4 * F.lane; float o[4], ss = 0.f;
#pragma unroll
            for (int j = 0; j < 4; ++j) { o[j] = orow[1024 + c + j]; ss += o[j] * o[j]; }
            const float ms = wave_sum(ss) * (1.0f / 256.0f); const float r = __builtin_amdgcn_rsqf(ms + EPS); float y[4];
#pragma unroll
            for (int j = 0; j < 4; ++j) y[j] = o[j] * r * ggl[c + j] * siluf_(bf2f(zr[ZC_GR + c + j]));
            v2u w; w.x = pk2(y[0], y[1]); w.y = pk2(y[2], y[3]); *(v2u*)(yr + 1024 + c) = w; }
    }
}
__device__ __forceinline__ void final_norm(const Args& a, Frame& F, const float* stats, const bf16* hb) {
    const GAS f32x4* gr = (const GAS f32x4*)a.g_final;
    f32x4 g0[4], g1[4];
#pragma unroll
    for (int j = 0; j < 4; ++j) { const int c4 = (64 * j + F.lane) * 2; g0[j] = gr[c4]; g1[j] = gr[c4 + 1]; }
    for (int m = F.gw; m < M; m += F.NGW) {
        GAS f32x4* orow = (GAS f32x4*)(a.out + (size_t)m * D);
        v4u h[4];
#pragma unroll
        for (int j = 0; j < 4; ++j) h[j] = *(const GAS v4u*)(hb + pg8::tile_rc(m, 8 * (F.lane + 64 * j), D));
        float sv = (F.lane < 32) ? stats[(size_t)m * 32 + F.lane] : 0.f; sv = wave_sum(sv);
        const float rstd = __builtin_amdgcn_rsqf(sv * (1.0f / D) + EPS);
#pragma unroll
        for (int j = 0; j < 4; ++j) { const int c4 = (64 * j + F.lane) * 2;
            const f32x4 o0 = {pg8::bf_lo(h[j].x), pg8::bf_hi(h[j].x), pg8::bf_lo(h[j].y), pg8::bf_hi(h[j].y)}, o1 = {pg8::bf_lo(h[j].z), pg8::bf_hi(h[j].z), pg8::bf_lo(h[j].w), pg8::bf_hi(h[j].w)};
            orow[c4] = o0 * rstd * g0[j]; orow[c4 + 1] = o1 * rstd * g1[j]; }
    }
}
__device__ __forceinline__ int fresh_bx() { int b = blockIdx.x; asm volatile("" : "+s"(b)); return b; }
constexpr int PH_PER_LAYER = 8;
constexpr int N_PHASES = 1 + DEPTH * PH_PER_LAYER + 1;

__global__ void __launch_bounds__(NWAVES * 64, 2) hyb_fwd(Args args) {
    extern __shared__ __attribute__((aligned(16))) unsigned char lds[];
    const int wave_s = __builtin_amdgcn_readfirstlane((int)threadIdx.x >> 6);
#define MKFRAME() Frame F; { F.lds = (LAS unsigned char*)lds; F.lane = pg8::fresh_lane(); F.wave = wave_s; F.tid = wave_s * 64 + F.lane; \
        F.G = gridDim.x; F.gw = blockIdx.x * NWAVES + F.wave; F.NGW = F.G * NWAVES; }
    LAS unsigned char* const ldsb = (LAS unsigned char*)lds;
    LAS float* const RTAB = (LAS float*)(ldsb + RTAB_OFF);
    volatile LAS unsigned* MISC = (volatile LAS unsigned*)(ldsb + MISC_OFF);
    for (int u = threadIdx.x; u < LDSCTL_BYTES / 4; u += NWAVES * 64) ((LAS unsigned*)(ldsb + LDSCTL_OFF))[u] = 0u;
    __syncthreads();
#define BARW ((unsigned*)(args.ws + WS_CTL) + CW_BAR)
    XcdBarrier bar; bar.bar = nullptr; bar.x = 0; bar.st = nullptr;
    const int lo = args.ph_lo, hi = args.ph_hi;

    if (hi - lo > 1) { bar = xcd_barrier_post(BARW, MISC + 8); bar.bar = nullptr; }
#define IN(k) (lo <= (k) && (k) < hi)
#define SEAM(k) do { if (IN(k) && IN((k) + 1)) { xcd_barrier(bar, BARW); for (int pb_ = 0; pb_ < PROBE_BAR; ++pb_) xcd_barrier(bar, BARW); } } while (0)

    if (IN(0)) { MKFRAME(); for (int pr_ = 0; pr_ <= PROBE_PRO; ++pr_) prologue(args, F); SEAM(0); }

#define PH_PTRS() GAS unsigned char* wsg_ = (GAS unsigned char*)args.ws; asm volatile("" : "+s"(wsg_)); unsigned char* ws = (unsigned char*)wsg_;     \
    float* const st_mix = (float*)(ws + WS_STATS); float* const st_mlp = (float*)(ws + WS_STATS + STATS_BYTES); float* const st_ple = (float*)(ws + WS_STATS + 2 * STATS_BYTES); \
    bf16* const Z = (bf16*)(ws + WS_UNION + UO_Z); bf16* const ABUF = (bf16*)(ws + WS_UNION + UO_A); bf16* const PP = (bf16*)(ws + WS_UNION + UO_PP); unsigned char* const H8 = ws + WS_UNION + UO_H8; \
    float* const GA = (float*)(ws + WS_GA); bf16* const PB = (bf16*)(ws + WS_PB); \
    bf16* const SB = (bf16*)(ws + WS_UNION + UO_S); bf16* const SSUP = (bf16*)(ws + WS_UNION + UO_SSUP); float* const DSUP = (float*)(ws + WS_DEC); \
    bf16* const hb = (bf16*)(ws + ((l & 1) ? WS_HBB : WS_HBA)); bf16* const yb = (bf16*)(ws + ((l & 1) ? WS_HBA : WS_HBB)); \
    unsigned char* const wl = ws + WS_W + (size_t)l * W_LAYER; \
    (void)H8; (void)st_mix; (void)st_mlp; (void)st_ple; (void)Z; (void)ABUF; (void)PP; (void)GA; (void)PB; (void)SB; (void)SSUP; (void)DSUP; (void)hb; (void)yb; (void)wl;

#pragma unroll 1
    for (int l = 0; l < DEPTH; ++l) {
        const int pbase = 1 + l * PH_PER_LAYER;

        if (IN(pbase + 0)) { PH_PTRS();
            pg8::Gemm g{hb, (const bf16*)(wl + WO_IN), M, ZW, D}; pg8::StaticOrder S; S.init(M, ZW, (int)gridDim.x, fresh_bx());
            pg8::EpiScaleBf16<0, true> E{Z, ZW, st_mix, RTAB};
            for (int pr_ = 0; pr_ < PROBE_GEMM; ++pr_) { pg8::EpiNull EN; pg8::gemm_phase<pg8::EpiNull, pg8::StaticOrder, PG8_ALIGN, PG8_SP2>(ldsb + RING_OFF, wave_s, g, S, EN); }
            for (int pq_ = 0; pq_ <= PROBE_GEMMR; ++pq_) pg8::gemm_phase<pg8::EpiScaleBf16<0, true>, pg8::StaticOrder, PG8_ALIGN, PG8_SP2, false, true>(ldsb + RING_OFF, wave_s, g, S, E);
            { MKFRAME(); ga_phase(args, F, hb, (const bf16*)(wl + WO_GA), st_mix, GA); }
            SEAM(pbase + 0);
        }
        if (IN(pbase + 1)) { PH_PTRS(); { MKFRAME(); pb_phase(args, F, l); } for (int pr_ = 0; pr_ <= PROBE_MIX; ++pr_) mx::mix_phase<false>(args, ldsb, wave_s, l, Z, GA, SB, SSUP, DSUP, yb); SEAM(pbase + 1); }
        if (IN(pbase + 2)) { PH_PTRS(); mx::scan_phase(wave_s, SSUP, DSUP); SEAM(pbase + 2); }
        if (IN(pbase + 3)) { PH_PTRS(); for (int pr_ = 0; pr_ <= PROBE_MIX; ++pr_) mx::mix_phase<true>(args, ldsb, wave_s, l, Z, GA, SB, SSUP, DSUP, yb); SEAM(pbase + 3); }
        if (IN(pbase + 4)) { PH_PTRS();
            pg8::Gemm g{yb, (const bf16*)(wl + WO_OUT), M, D, D}; pg8::StaticOrder S; S.init(M, D, (int)gridDim.x, fresh_bx());
            pg8::EpiResidual<0> E{hb, hb, st_mlp, nullptr, nullptr, D, RTAB, nullptr};
            for (int pr_ = 0; pr_ < PROBE_GEMM; ++pr_) { pg8::EpiNull EN; pg8::gemm_phase<pg8::EpiNull, pg8::StaticOrder, PG8_ALIGN, PG8_SP2>(ldsb + RING_OFF, wave_s, g, S, EN); }
            pg8::gemm_phase<pg8::EpiResidual<0>, pg8::StaticOrder, PG8_ALIGN, PG8_SP2, false, true>(ldsb + RING_OFF, wave_s, g, S, E);
            SEAM(pbase + 4);
        }
        if (IN(pbase + 5)) { PH_PTRS();
            { pg8::Gemm g{hb, (const bf16*)(wl + WO_UP), M, FF, D}; pg8::StaticOrder S; S.init(M, FF, (int)gridDim.x, fresh_bx());
              pg8::EpiScaleBf16<1, true> E{ABUF, FF, st_mlp, RTAB};
              for (int pr_ = 0; pr_ < PROBE_GEMM; ++pr_) { pg8::EpiNull EN; pg8::gemm_phase<pg8::EpiNull, pg8::StaticOrder, PG8_ALIGN, PG8_SP2>(ldsb + RING_OFF, wave_s, g, S, EN); }
            for (int pq_ = 0; pq_ <= PROBE_GEMMR; ++pq_) pg8::gemm_phase<pg8::EpiScaleBf16<1, true>, pg8::StaticOrder, PG8_ALIGN, PG8_SP2, false, true>(ldsb + RING_OFF, wave_s, g, S, E); }
            SEAM(pbase + 5);
        }
        if (IN(pbase + 6)) { PH_PTRS();
            pg8::Gemm g{ABUF, (const bf16*)(wl + WO_DN), M, D, FF}; pg8::StaticOrder S; S.init(M, D, (int)gridDim.x, fresh_bx(), 4);
            pg8::EpiResidual<2> E{hb, hb, st_ple, nullptr, nullptr, D, RTAB, H8};
            for (int pr_ = 0; pr_ < PROBE_GEMM; ++pr_) { pg8::EpiNull EN; pg8::gemm_phase<pg8::EpiNull, pg8::StaticOrder, PG8_ALIGN, PG8_SP2>(ldsb + RING_OFF, wave_s, g, S, EN); }
            pg8::gemm_phase<pg8::EpiResidual<2>, pg8::StaticOrder, PG8_ALIGN, PG8_SP2, false, true>(ldsb + RING_OFF, wave_s, g, S, E);
            SEAM(pbase + 6);
        }
        if (IN(pbase + 7)) { PH_PTRS();
            { pg8::Gemm g{PB, (const bf16*)(wl + WO_PP), M, D, PLE}; pg8::StaticOrder S; S.init(M, D, (int)gridDim.x, fresh_bx());
              pg8::EpiScaleBf16<2, true> E{PP, D, nullptr, RTAB};
              for (int pr_ = 0; pr_ < PROBE_GEMM; ++pr_) { pg8::EpiNull EN; pg8::gemm_phase<pg8::EpiNull, pg8::StaticOrder, PG8_ALIGN, PG8_SP2>(ldsb + RING_OFF, wave_s, g, S, EN); }
            for (int pq_ = 0; pq_ <= PROBE_GEMMR; ++pq_) pg8::gemm_phase<pg8::EpiScaleBf16<2, true>, pg8::StaticOrder, PG8_ALIGN, PG8_SP2>(ldsb + RING_OFF, wave_s, g, S, E); }
            pg8::Gemm g{(const bf16*)H8, (const bf16*)(wl + WO_PG), M, D, D / 2}; pg8::StaticOrder S; S.init(M, D, (int)gridDim.x, fresh_bx());
            pg8::EpiResidual<1> E{hb, yb, st_mix, st_ple, PP, D, RTAB, nullptr};
            for (int pr_ = 0; pr_ < PROBE_GEMM; ++pr_) { pg8::EpiNull EN; pg8::gemm_phase<pg8::EpiNull, pg8::StaticOrder, PG8_ALIGN, PG8_SP2, true>(ldsb + RING_OFF, wave_s, g, S, EN); }
            int np5_ = PROBE_G5 + 1; asm volatile("" : "+s"(np5_));
#pragma unroll 1
            for (int pq_ = 0; pq_ < np5_; ++pq_) pg8::gemm_phase<pg8::EpiResidual<1>, pg8::StaticOrder, PG8_ALIGN, PG8_SP2, true, true>(ldsb + RING_OFF, wave_s, g, S, E);
            SEAM(pbase + 7);
        }
    }
    if (IN(N_PHASES - 1)) { const int l = DEPTH; PH_PTRS(); MKFRAME(); final_norm(args, F, st_mix, hb); }

#undef IN
#undef SEAM
}

extern "C" void kernel_launch(void* const* d_in, const int* in_sizes, int n_in, void* d_out, int out_size, void* d_ws, size_t ws_size, hipStream_t stream) {
    static int grid = 0;
    if (grid == 0) {
        if (n_in != 18 || out_size != M * D || ws_size < WS_END) { fprintf(stderr, "kernel_launch: unexpected shapes (n_in %d out %d ws %zu, need %zu); nothing launched\n", n_in, out_size, ws_size, (size_t)WS_END); grid = -1; return; }
        int dev = 0, cus = 0, per_cu = 0;
        if (hipGetDevice(&dev) != hipSuccess || hipDeviceGetAttribute(&cus, hipDeviceAttributeMultiprocessorCount, dev) != hipSuccess) { grid = -1; return; }
        if (hipFuncSetAttribute((const void*)hyb_fwd, hipFuncAttributeMaxDynamicSharedMemorySize, LDS_BYTES) != hipSuccess) { fprintf(stderr, "kernel_launch: hipFuncSetAttribute failed\n"); grid = -1; return; }
        if (hipOccupancyMaxActiveBlocksPerMultiprocessor(&per_cu, (const void*)hyb_fwd, NWAVES * 64, LDS_BYTES) != hipSuccess || per_cu < 1) { fprintf(stderr, "kernel_launch: occupancy query says %d\n", per_cu); }
        (void)hipGetLastError();
        grid = cus;
    }
    if (grid < 0) return;
    if (hipMemsetAsync((char*)d_ws + WS_CTL, 0, CTL_ZERO_BYTES, stream) != hipSuccess) return;
    Args a{};
    const float** pa = (const float**)&a;
    for (int i = 0; i < 18; ++i) pa[i] = (const float*)d_in[i];
    a.out = (float*)d_out; a.ws = (unsigned char*)d_ws;
#if MK_MULTI
    for (int ph = 0; ph < N_PHASES; ++ph) { a.ph_lo = ph; a.ph_hi = ph + 1; hipLaunchKernelGGL(hyb_fwd, dim3(grid), dim3(NWAVES * 64), LDS_BYTES, stream, a); }
#else
    a.ph_lo = 0; a.ph_hi = N_PHASES;
    hipLaunchKernelGGL(hyb_fwd, dim3(grid), dim3(NWAVES * 64), LDS_BYTES, stream, a);
#endif
}
```

```cpp
#include <hip/hip_runtime.h>
#include <cstdio>
#include <cstdint>

#ifndef PROBE_GEMM
#define PROBE_GEMM 0
#endif
#ifndef PROBE_MIX
#define PROBE_MIX 0
#endif
#ifndef PROBE_BAR
#define PROBE_BAR 0
#endif
#ifndef PROBE_SCAN
#define PROBE_SCAN 0
#endif
#ifndef PROBE_GEMMR
#define PROBE_GEMMR 0
#endif
#ifndef PROBE_PRO
#define PROBE_PRO 0
#endif
#ifndef PROBE_G5
#define PROBE_G5 0
#endif
#ifndef MK_MULTI
#define MK_MULTI 0
#endif

namespace pg8 {
#define PG8_LAS __attribute__((address_space(3)))
typedef unsigned short bf16_t;
typedef short bf16x8 __attribute__((ext_vector_type(8)));
typedef float f32x4 __attribute__((ext_vector_type(4)));
typedef unsigned u32x4 __attribute__((ext_vector_type(4)));
typedef unsigned u32x2 __attribute__((ext_vector_type(2)));
constexpr int BM = 256, BK = 64, HALF = 128, HTB = HALF * BK * 2  , STAGE_BYTES = 8 * HTB, NXCD = 8, WGM = 8;

__host__ __device__ __forceinline__ int lds_byte(int r, int c) { const int st = (r >> 4) * 2 + (c >> 5), rr = r & 15, cc = c & 31, ob = rr * 64 + cc * 2; return st * 1024 + (ob ^ (((ob >> 9) & 1) << 5)); }
__host__ __device__ __forceinline__ void stage_rc(int b, int& R, int& C) { const int st = b / 1024, sb = b % 1024, swz = sb ^ (((sb >> 9) & 1) << 5); R = (st >> 1) * 16 + swz / 64; C = (st & 1) * 32 + (swz % 64) / 2; }
__host__ __device__ __forceinline__ int perm32(int rho) { const int n = rho >> 4, i = rho & 15; return 8 * (i >> 2) + 4 * n + (i & 3); }

struct Unit { int pm, pn; };
struct Gemm { const bf16_t* A; const bf16_t* Bt; int M, N, K; };

struct StaticOrder {
    int nM, nN, nwg, G, c, wgm;
    __host__ __device__ void init(int M, int N, int G_, int c_, int wgm_ = WGM) { nM = M / BM; nN = N / BM; nwg = nM * nN; G = G_; c = c_; wgm = wgm_; }
    __host__ __device__ bool next(int i, Unit& u) const {
        const long L = (long)i * G + c; if (L >= nwg) return false;
        int wgid = (int)L; { const int q = nwg / NXCD, r = nwg % NXCD, xcd = wgid % NXCD, off = wgid / NXCD; wgid = (xcd < r ? xcd * (q + 1) : r * (q + 1) + (xcd - r) * q) + off; }
        const int nig = wgm * nN, gid = wgid / nig, fm = gid * wgm, gsz = (nM - fm) < wgm ? (nM - fm) : wgm;
        u.pm = fm + ((wgid % nig) % gsz); u.pn = (wgid % nig) / gsz; return true;
    }
    __device__ __forceinline__ void a_ready(const Unit&) const {}
    __device__ __forceinline__ void done(const Unit&) const {}
};

typedef __bf16 bf16x2_t __attribute__((ext_vector_type(2)));
typedef float f32x2_t __attribute__((ext_vector_type(2)));
__device__ __forceinline__ unsigned cvt_pk_bf16(float lo, float hi) { const f32x2_t f = {lo, hi}; const bf16x2_t b = __builtin_convertvector(f, bf16x2_t); return __builtin_bit_cast(unsigned, b); }
__device__ __forceinline__ float bf_lo(unsigned w) { return __uint_as_float(w << 16); }
__device__ __forceinline__ float bf_hi(unsigned w) { return __uint_as_float(w & 0xffff0000u); }
__device__ __forceinline__ unsigned cvt_pk_fp8x4(float a, float b, float c, float d) { int w = 0; w = __builtin_amdgcn_cvt_pk_fp8_f32(a, b, w, false); w = __builtin_amdgcn_cvt_pk_fp8_f32(c, d, w, true); return (unsigned)w; }
typedef int i32x4_t __attribute__((ext_vector_type(4)));
typedef int i32x8_t __attribute__((ext_vector_type(8)));
__device__ __forceinline__ i32x8_t cat8(bf16x8 lo, bf16x8 hi) { const i32x4_t a = __builtin_bit_cast(i32x4_t, lo), b = __builtin_bit_cast(i32x4_t, hi); return __builtin_shufflevector(a, b, 0, 1, 2, 3, 4, 5, 6, 7); }
__device__ __forceinline__ float sum_xor16(float v) { const unsigned b = __builtin_bit_cast(unsigned, v); const auto r = __builtin_amdgcn_permlane16_swap(b, b, false, false); return __builtin_bit_cast(float, (unsigned)r[0]) + __builtin_bit_cast(float, (unsigned)r[1]); }
__device__ __forceinline__ float sum_xor32(float v) { const unsigned b = __builtin_bit_cast(unsigned, v); const auto r = __builtin_amdgcn_permlane32_swap(b, b, false, false); return __builtin_bit_cast(float, (unsigned)r[0]) + __builtin_bit_cast(float, (unsigned)r[1]); }
template <int CTRL> __device__ __forceinline__ float dpp_get(float v) { return __builtin_bit_cast(float, __builtin_amdgcn_mov_dpp(__builtin_bit_cast(int, v), CTRL, 0xF, 0xF, true)); }
__device__ __forceinline__ float get_xor1(float v) { return __builtin_bit_cast(float, __builtin_amdgcn_mov_dpp(__builtin_bit_cast(int, v), 0xB1, 0xF, 0xF, true)); }
constexpr float F8_WSCALE = 64.0f;

constexpr float RMS_EPS = 1e-6f;
constexpr int DMODEL = 2048;
constexpr int NSTAT = 32;

__device__ __forceinline__ void rstd_table(const float* stats, int pm, int wid, int lane, PG8_LAS float* tab) {
    const int t = wid * 64 + lane, row = t >> 1, half = t & 1;
    const f32x4* p = (const f32x4*)(stats + (size_t)(pm * BM + row) * NSTAT + half * 16);
    const f32x4 a = p[0], b = p[1], c = p[2], d = p[3];
    float s = (((a[0] + a[1]) + (a[2] + a[3])) + ((b[0] + b[1]) + (b[2] + b[3]))) + (((c[0] + c[1]) + (c[2] + c[3])) + ((d[0] + d[1]) + (d[2] + d[3])));
    s += get_xor1(s);
    if (half == 0) tab[row] = __builtin_amdgcn_rsqf(s * (1.0f / DMODEL) + RMS_EPS);
}

__host__ __device__ __forceinline__ size_t tile_rc(int row, int col, int ld) { return (((size_t)(row >> 4) * (ld >> 5) + (col >> 5)) << 9) + (row & 15) * 32 + (col & 31); }
__device__ __forceinline__ size_t tiled_off(int row, int ldc, int pn, int wc, int bj, int fq) { return (((size_t)(row >> 4) * (ldc >> 5) + pn * 8 + wc + bj * 4) << 9) + (row & 15) * 32 + 8 * fq; }
template <int ACT, bool TILED = false, bool BLK = false> struct EpiScaleBf16 {
    static constexpr bool PERM = true, AFTER_DRAIN = false;
    bf16_t* O; int ldc; const float* stats; PG8_LAS float* tab;
    __device__ __forceinline__ void prepare(const Unit& u, int wid, int lane, int par) const { if (ACT != 2) rstd_table(stats, u.pm, wid, lane, tab + par * 256); }
    __device__ __forceinline__ void operator()(const f32x4 (&acc)[2][2][4][2], const Unit& u, int wr, int wc, int fr, int fq, int wid, int lane, int par) const {
        const int rl0 = wr * 64 + fr, col0 = u.pn * BM + wc * 32 + 8 * fq;
#pragma unroll
        for (int ai = 0; ai < 2; ++ai)
#pragma unroll
            for (int m = 0; m < 4; ++m) { const int rl = rl0 + ai * HALF + m * 16; bf16_t* rowp = O + (size_t)(u.pm * BM + rl) * ldc + col0;
                float sc = 1.0f; if (ACT != 2) sc = tab[par * 256 + rl];
#pragma unroll
                for (int bj = 0; bj < 2; ++bj) { f32x4 v0 = acc[ai][bj][m][0] * sc, v1 = acc[ai][bj][m][1] * sc;
                    if (ACT == 1) {
#pragma unroll
                        for (int j = 0; j < 4; ++j) { const float a0 = fmaxf(v0[j], 0.f), a1 = fmaxf(v1[j], 0.f); v0[j] = a0 * a0; v1[j] = a1 * a1; } }
                    u32x4 w; w.x = cvt_pk_bf16(v0[0], v0[1]); w.y = cvt_pk_bf16(v0[2], v0[3]); w.z = cvt_pk_bf16(v1[0], v1[1]); w.w = cvt_pk_bf16(v1[2], v1[3]);
                    if constexpr (TILED) {
                        const int row = u.pm * BM + rl;
                        if constexpr (BLK) *(u32x4*)(O + (((((size_t)u.pm * (ldc >> 8) + u.pn) * 16 + ((row >> 4) & 15)) * 8 + wc + bj * 4) << 9) + (row & 15) * 32 + 8 * fq) = w;
                        else *(u32x4*)(O + (((size_t)(row >> 4) * (ldc >> 5) + u.pn * 8 + wc + bj * 4) << 9) + (row & 15) * 32 + 8 * fq) = w;
                    } else *(u32x4*)(rowp + bj * HALF) = w; } }
    }
};

template <int MODE> struct EpiResidual {
    static constexpr bool PERM = true, AFTER_DRAIN = false;
    const bf16_t* hin; bf16_t* hout; float* stats_out; const float* stats_in; const bf16_t* pp; int ldc; PG8_LAS float* tab; unsigned char* h8;
    __device__ __forceinline__ void prepare(const Unit& u, int wid, int lane, int par) const { if (MODE == 1) rstd_table(stats_in, u.pm, wid, lane, tab + par * 256); }
    __device__ __forceinline__ void operator()(const f32x4 (&acc)[2][2][4][2], const Unit& u, int wr, int wc, int fr, int fq, int wid, int lane, int par) const {
        const int rl0 = wr * 64 + fr, col0 = u.pn * BM + wc * 32 + 8 * fq;
#pragma unroll
        for (int ai = 0; ai < 2; ++ai) {
            u32x4 hv[4][2], pw[4][2];
#pragma unroll
            for (int m = 0; m < 4; ++m) { const size_t off = (size_t)(u.pm * BM + rl0 + ai * HALF + m * 16) * ldc + col0;
#pragma unroll
                for (int bj = 0; bj < 2; ++bj) { hv[m][bj] = *(const u32x4*)(hin + tiled_off(u.pm * BM + rl0 + ai * HALF + m * 16, ldc, u.pn, wc, bj, fq)); if (MODE == 1) pw[m][bj] = *(const u32x4*)(pp + tiled_off(u.pm * BM + rl0 + ai * HALF + m * 16, ldc, u.pn, wc, bj, fq)); } }
#pragma unroll
            for (int m = 0; m < 4; ++m) { const int rl = rl0 + ai * HALF + m * 16, row = u.pm * BM + rl; const size_t off = (size_t)row * ldc + col0; float ss = 0.f;
                float sc2 = 0.f; if (MODE == 1) sc2 = tab[par * 256 + rl] * (-1.4426950408889634f / F8_WSCALE);
#pragma unroll
                for (int bj = 0; bj < 2; ++bj) {
                    f32x4 v0 = acc[ai][bj][m][0], v1 = acc[ai][bj][m][1];
                    if (MODE == 1) {
                        const u32x4 q = pw[m][bj];
                        const float pv[8] = {bf_lo(q.x), bf_hi(q.x), bf_lo(q.y), bf_hi(q.y), bf_lo(q.z), bf_hi(q.z), bf_lo(q.w), bf_hi(q.w)};
#pragma unroll
                        for (int j = 0; j < 4; ++j) {
                            const float g0 = __builtin_amdgcn_rcpf(1.0f + __builtin_amdgcn_exp2f(v0[j] * sc2)), g1 = __builtin_amdgcn_rcpf(1.0f + __builtin_amdgcn_exp2f(v1[j] * sc2));
                            v0[j] = g0 * pv[j]; v1[j] = g1 * pv[4 + j]; }
                    }
                    const u32x4 h = hv[m][bj];
                    v0 = v0 + (f32x4){bf_lo(h.x), bf_hi(h.x), bf_lo(h.y), bf_hi(h.y)}; v1 = v1 + (f32x4){bf_lo(h.z), bf_hi(h.z), bf_lo(h.w), bf_hi(h.w)};
                    u32x4 w; w.x = cvt_pk_bf16(v0[0], v0[1]); w.y = cvt_pk_bf16(v0[2], v0[3]); w.z = cvt_pk_bf16(v1[0], v1[1]); w.w = cvt_pk_bf16(v1[2], v1[3]);
                    *(u32x4*)(hout + tiled_off(row, ldc, u.pn, wc, bj, fq)) = w;
                    if (MODE == 2) { u32x2 w8; w8.x = cvt_pk_fp8x4(v0[0], v0[1], v0[2], v0[3]); w8.y = cvt_pk_fp8x4(v1[0], v1[1], v1[2], v1[3]); const int bc = u.pn * BM + bj * HALF + wc * 32 + 8 * fq;
                        *(u32x2*)(h8 + ((((size_t)(row >> 4) * (ldc >> 6)) + (bc >> 6)) << 10) + (row & 15) * 64 + (bc & 63)) = w8; }
                    ss += (v0[0] * v0[0] + v0[1] * v0[1]) + (v0[2] * v0[2] + v0[3] * v0[3]) + (v1[0] * v1[0] + v1[1] * v1[1]) + (v1[2] * v1[2] + v1[3] * v1[3]);
                }
                ss = sum_xor16(ss); ss = sum_xor32(ss);
                if (fq == 0) stats_out[(size_t)row * NSTAT + u.pn * 4 + wc] = ss;
            }
            asm volatile("" ::: "memory");
        }
    }
};

struct EpiNull { static constexpr bool PERM = true, AFTER_DRAIN = false;
    __device__ __forceinline__ void prepare(const Unit&, int, int, int) const {}
    __device__ __forceinline__ void operator()(const f32x4 (&acc)[2][2][4][2], const Unit&, int, int, int, int, int, int, int) const {
#pragma unroll
        for (int a = 0; a < 2; ++a)
#pragma unroll
            for (int b = 0; b < 2; ++b)
#pragma unroll
                for (int m = 0; m < 4; ++m)
#pragma unroll
                    for (int n = 0; n < 2; ++n) asm volatile("" :: "v"(acc[a][b][m][n])); } };
__device__ __forceinline__ int fresh_lane() { int l; asm volatile("v_mbcnt_lo_u32_b32 %0, -1, 0\n\tv_mbcnt_hi_u32_b32 %0, -1, %0" : "=v"(l)); return l; }
template <class Epi, class Sched, bool ALIGN_EPI = false, bool SP2 = false, bool FP8 = false, bool ATILED = false, bool BTILED = true, bool ABLK = false>
__device__ __forceinline__ void gemm_phase(PG8_LAS unsigned char* lds, const int wid_in, const Gemm g, const Sched& S, const Epi& E) {
    int wid = wid_in; asm volatile("" : "+s"(wid));
    const int lane = fresh_lane(), tid = wid * 64 + lane, wr = wid >> 2, wc = wid & 3, fr = lane & 15, fq = lane >> 4;
    const int K = g.K, nt = K / BK;
    unsigned voffA[2], voffB[2];
#pragma unroll
    for (int i = 0; i < 2; ++i) { int R, C; stage_rc(tid * 16 + i * 8192, R, C); const int Rb = Epi::PERM ? ((R & ~31) + perm32(R & 31)) : R;
        voffA[i] = ABLK ? (unsigned)((((R >> 4) * 8 + (C >> 5)) << 10) + (R & 15) * 64 + (C & 31) * 2) : ATILED ? (unsigned)((((R >> 4) * (K >> 5) + (C >> 5)) << 10) + (R & 15) * 64 + (C & 31) * 2) : (unsigned)(R * K + C) * 2u; voffB[i] = BTILED ? (unsigned)((((R >> 4) * (K >> 5) + (C >> 5)) << 10) + (R & 15) * 64 + (C & 31) * 2) : (unsigned)(Rb * K + C) * 2u; }
    const size_t kstep = (size_t)(BK * 2);
    const size_t kstepA = ATILED ? (size_t)2048 : kstep;
    const size_t kstepB = BTILED ? (size_t)2048 : kstep;
    const size_t hstep = (size_t)HALF * K * 2;
    const size_t hstepA = ABLK ? (size_t)65536 : hstep;
    const size_t tstep = 2 * hstep;
    const unsigned ldsw = (unsigned)wid * 1024u;
    const int aoff = lds_byte(wr * 64 + fr, fq * 8), boff = lds_byte(wc * 32 + fr, fq * 8);
#define PG8_SA(b, h) (((b) * 2 + (h)) * HTB)
#define PG8_SB(b, h) ((4 + (b) * 2 + (h)) * HTB)
#define PG8_STAGE(bufoff, gbase, voff) do { _Pragma("unroll") for (int _i = 0; _i < 2; ++_i) { unsigned _vo = (voff)[_i]; if constexpr (FP8) asm volatile("" : "+v"(_vo));    \
        __builtin_amdgcn_global_load_lds((const unsigned*)((const char*)(gbase) + _vo), (PG8_LAS unsigned*)(lds + (bufoff) + ldsw + _i * 8192), 16, 0, 0); } } while (0)
#define PG8_LDA(dst, b, h) do { _Pragma("unroll") for (int m = 0; m < 4; ++m) _Pragma("unroll") for (int k = 0; k < 2; ++k) dst[m][k] = *(const PG8_LAS bf16x8*)(lds + PG8_SA(b, h) + aoff + m * 2048 + k * 1024); } while (0)
#define PG8_LDB(dst, b, h) do { _Pragma("unroll") for (int n = 0; n < 2; ++n) _Pragma("unroll") for (int k = 0; k < 2; ++k) dst[n][k] = *(const PG8_LAS bf16x8*)(lds + PG8_SB(b, h) + boff + n * 2048 + k * 1024); } while (0)
#define PG8_MMA(ai, bj, At, Bt) do { __builtin_amdgcn_s_setprio(1); _Pragma("unroll") for (int m = 0; m < 4; ++m) _Pragma("unroll") for (int n = 0; n < 2; ++n) { \
        if constexpr (FP8) acc[ai][bj][m][n] = __builtin_amdgcn_mfma_scale_f32_16x16x128_f8f6f4(cat8(Bt[n][0], Bt[n][1]), cat8(At[m][0], At[m][1]), acc[ai][bj][m][n], 0, 0, 0, 0, 0, 0);   \
        else { _Pragma("unroll") for (int k = 0; k < 2; ++k) acc[ai][bj][m][n] = __builtin_amdgcn_mfma_f32_16x16x32_bf16(Bt[n][k], At[m][k], acc[ai][bj][m][n], 0, 0, 0); } } \
        __builtin_amdgcn_s_setprio(0); } while (0)
#define PG8_WAIT_V(n) asm volatile("s_waitcnt vmcnt(" #n ")" ::: "memory")
#define PG8_WAIT_L(n) asm volatile("s_waitcnt lgkmcnt(" #n ")" ::: "memory")
#define PG8_BAR __builtin_amdgcn_s_barrier()
#define PG8_SCHED __builtin_amdgcn_sched_barrier(0)
    Unit cur, nxt; int ui = 0;
    if (!S.next(0, cur)) return;
    f32x4 acc[2][2][4][2];
#pragma unroll
    for (int a = 0; a < 2; ++a)
#pragma unroll
        for (int b = 0; b < 2; ++b)
#pragma unroll
            for (int m = 0; m < 4; ++m)
#pragma unroll
                for (int n = 0; n < 2; ++n) acc[a][b][m][n] = (f32x4){0.f, 0.f, 0.f, 0.f};
    bf16x8 At[4][2], B0[2][2], B1[2][2];
    const char* cA = (const char*)g.A + (size_t)cur.pm * tstep; const char* cB = (const char*)g.Bt + (size_t)cur.pn * tstep;
    S.a_ready(cur);
    if constexpr (SP2) {
        PG8_STAGE(PG8_SB(0, 0), cB, voffB); PG8_STAGE(PG8_SB(0, 1), cB + hstep, voffB); PG8_STAGE(PG8_SA(0, 0), cA, voffA); PG8_STAGE(PG8_SA(0, 1), cA + hstepA, voffA);
        E.prepare(cur, wid, lane, 0);
        if (wr == 1) PG8_BAR;
        PG8_WAIT_V(2); PG8_BAR;
        PG8_STAGE(PG8_SB(1, 0), cB + kstepB, voffB); PG8_STAGE(PG8_SA(1, 0), cA + kstepA, voffA); PG8_STAGE(PG8_SB(1, 1), cB + hstep + kstepB, voffB);
        PG8_WAIT_V(6); PG8_BAR;
    } else {
        PG8_STAGE(PG8_SB(0, 0), cB, voffB); PG8_STAGE(PG8_SA(0, 0), cA, voffA); PG8_STAGE(PG8_SB(0, 1), cB + hstep, voffB); PG8_STAGE(PG8_SA(0, 1), cA + hstepA, voffA);
        E.prepare(cur, wid, lane, 0);
        if (wr == 1) PG8_BAR;
        PG8_WAIT_V(4); PG8_BAR;
        PG8_STAGE(PG8_SB(1, 0), cB + kstepB, voffB); PG8_STAGE(PG8_SA(1, 0), cA + kstepA, voffA); PG8_STAGE(PG8_SB(1, 1), cB + hstep + kstepB, voffB);
        PG8_WAIT_V(6); PG8_BAR;
    }
    for (;;) {
        const bool has_next = S.next(ui + 1, nxt);
        const char* nA = has_next ? (const char*)g.A + (size_t)nxt.pm * tstep : cA; const char* nB = has_next ? (const char*)g.Bt + (size_t)nxt.pn * tstep : cB;
#pragma unroll 1
        for (int t = 0; t < nt; t += 2) {
            const bool last = (t == nt - 2);
            const char* a1 = ABLK ? cA + (size_t)(t >> 2) * 131072 + (size_t)((t & 3) + 1) * 2048 : cA + (size_t)(t + 1) * kstepA;
            const char* a2 = last ? nA : (ABLK ? cA + (size_t)((t + 2) >> 2) * 131072 + (size_t)((t + 2) & 3) * 2048 : cA + (size_t)(t + 2) * kstepA); const char* b2 = last ? nB : cB + (size_t)(t + 2) * kstepB;
            const char* a3 = a2 + kstepA; const char* b3 = b2 + kstepB;
            if (last && has_next) S.a_ready(nxt);
            if constexpr (SP2) {
            PG8_LDB(B0, 0, 0); PG8_LDB(B1, 0, 1); PG8_SCHED; PG8_LDA(At, 0, 0); PG8_STAGE(PG8_SA(1, 1), a1 + hstepA, voffA);
            PG8_WAIT_V(8); PG8_WAIT_L(0); PG8_BAR; PG8_MMA(0, 0, At, B0); PG8_MMA(0, 1, At, B1); PG8_BAR; PG8_SCHED;
            PG8_LDA(At, 0, 1); PG8_STAGE(PG8_SB(0, 0), b2, voffB); PG8_STAGE(PG8_SB(0, 1), b2 + hstep, voffB); PG8_STAGE(PG8_SA(0, 0), a2, voffA);
            PG8_WAIT_V(8); PG8_WAIT_L(0); PG8_BAR; PG8_MMA(1, 0, At, B0); PG8_MMA(1, 1, At, B1); PG8_BAR; PG8_SCHED;
            PG8_LDB(B0, 1, 0); PG8_LDB(B1, 1, 1); PG8_SCHED; PG8_LDA(At, 1, 0); PG8_STAGE(PG8_SA(0, 1), a2 + hstepA, voffA);
            PG8_WAIT_V(8); PG8_WAIT_L(0); PG8_BAR; PG8_MMA(0, 0, At, B0); PG8_MMA(0, 1, At, B1); PG8_BAR; PG8_SCHED;
            PG8_LDA(At, 1, 1); PG8_STAGE(PG8_SB(1, 0), b3, voffB); PG8_STAGE(PG8_SB(1, 1), b3 + hstep, voffB); PG8_STAGE(PG8_SA(1, 0), a3, voffA);
            PG8_WAIT_V(8); PG8_WAIT_L(0); PG8_BAR; PG8_MMA(1, 0, At, B0); PG8_MMA(1, 1, At, B1); PG8_BAR; PG8_SCHED;
            } else {
            PG8_LDB(B0, 0, 0); PG8_SCHED; PG8_LDA(At, 0, 0); PG8_STAGE(PG8_SA(1, 1), a1 + hstepA, voffA);
            PG8_WAIT_L(8); PG8_BAR; PG8_WAIT_L(0); PG8_MMA(0, 0, At, B0); PG8_BAR; PG8_SCHED;
            PG8_LDB(B1, 0, 1); PG8_STAGE(PG8_SB(0, 0), b2, voffB);
            PG8_BAR; PG8_WAIT_L(0); PG8_MMA(0, 1, At, B1); PG8_BAR;
            PG8_LDA(At, 0, 1); PG8_STAGE(PG8_SA(0, 0), a2, voffA);
            PG8_BAR; PG8_WAIT_L(0); PG8_MMA(1, 0, At, B0); PG8_BAR; PG8_SCHED;
            PG8_STAGE(PG8_SB(0, 1), b2 + hstep, voffB);
            PG8_WAIT_V(6); PG8_BAR; PG8_MMA(1, 1, At, B1); PG8_BAR;
            PG8_LDB(B0, 1, 0); PG8_SCHED; PG8_LDA(At, 1, 0); PG8_STAGE(PG8_SA(0, 1), a2 + hstepA, voffA);
            PG8_WAIT_L(8); PG8_BAR; PG8_WAIT_L(0); PG8_MMA(0, 0, At, B0); PG8_BAR; PG8_SCHED;
            PG8_LDB(B1, 1, 1); PG8_STAGE(PG8_SB(1, 0), b3, voffB);
            PG8_BAR; PG8_WAIT_L(0); PG8_MMA(0, 1, At, B1); PG8_BAR;
            PG8_LDA(At, 1, 1); PG8_STAGE(PG8_SA(1, 0), a3, voffA);
            PG8_BAR; PG8_WAIT_L(0); PG8_MMA(1, 0, At, B0); PG8_BAR; PG8_SCHED;
            PG8_STAGE(PG8_SB(1, 1), b3 + hstep, voffB);
            PG8_WAIT_V(6); PG8_BAR; PG8_MMA(1, 1, At, B1); PG8_BAR;
            }
        }
        if constexpr (ALIGN_EPI) { if (wr == 0) PG8_BAR; }
        { const int l2 = fresh_lane(); E(acc, cur, wr, wc, l2 & 15, l2 >> 4, wid, l2, ui & 1); } S.done(cur);
        if (!has_next) break;
#pragma unroll
        for (int a = 0; a < 2; ++a)
#pragma unroll
            for (int b = 0; b < 2; ++b)
#pragma unroll
                for (int m = 0; m < 4; ++m)
#pragma unroll
                    for (int n = 0; n < 2; ++n) acc[a][b][m][n] = (f32x4){0.f, 0.f, 0.f, 0.f};
        cur = nxt; cA = nA; cB = nB; ++ui;
        if constexpr (ALIGN_EPI) { if (wr == 1) PG8_BAR; }
        { const int l3 = fresh_lane(); E.prepare(cur, wid, l3, ui & 1); }
    }
    PG8_WAIT_V(0);
    if constexpr (!ALIGN_EPI) { if (wr == 0) PG8_BAR; }
    PG8_BAR;
#undef PG8_SA
#undef PG8_SB
#undef PG8_STAGE
#undef PG8_LDA
#undef PG8_LDB
#undef PG8_MMA
#undef PG8_WAIT_V
#undef PG8_WAIT_L
#undef PG8_BAR
#undef PG8_SCHED
}
}

#ifndef PG8_SP2
#define PG8_SP2 true
#endif
#ifndef PG8_ALIGN
#define PG8_ALIGN true
#endif

constexpr int NWAVES = 8;
constexpr int M = 16384, D = 2048, DEPTH = 4, FF = 8192, INW = 7184, ZW = 7168, PLE = 256;
constexpr int HGW = 1024, HGH = 8, HD = 128;
constexpr int GH = 4, GDK = 128, GDV = 256, GKW = 512, GLAW = 1024, GRANK = 16;
constexpr int ZC_HQ = 0, ZC_HF = 1024, ZC_HI = 2048, ZC_HG = 3072, ZC_GQ = 4096, ZC_GK = 4608, ZC_GV = 5120, ZC_GR = 6144;
constexpr int CONVC = 2048;
constexpr float EPS = 1e-6f;
constexpr int CHUNK = 64, NCHUNK = M / CHUNK;

constexpr size_t MiB = 1u << 20;
constexpr size_t WS_CTL = 0, CTL_ZERO_BYTES = 1 * MiB;
constexpr size_t WS_STATS = 1 * MiB;
constexpr size_t STATS_BYTES = (size_t)M * 32 * 4;
constexpr size_t WS_GA = 7 * MiB;
constexpr size_t WS_DEC = 8 * MiB;
constexpr size_t WS_PB = 12 * MiB;
constexpr size_t WS_HBA = 20 * MiB, WS_HBB = 84 * MiB;
constexpr size_t WS_W = 148 * MiB, W_LAYER = 110 * MiB;
constexpr size_t WO_IN = 0, WO_OUT = 28 * MiB, WO_UP = 36 * MiB, WO_DN = 68 * MiB, WO_PG = 100 * MiB, WO_PP = 108 * MiB, WO_GA = 109 * MiB;
constexpr size_t WS_UNION = 588 * MiB;
constexpr size_t UO_Z = 0, UO_OBUF = 224 * MiB, UO_S = 224 * MiB, UO_SSUP = 352 * MiB, UO_A = 0, UO_PP = 256 * MiB, UO_H8 = 320 * MiB  ;
constexpr size_t WS_END = 972 * MiB;

constexpr int CW_BAR = 4096;

constexpr int RING_OFF = 0, RING_BYTES = 131072;
constexpr int LDS_BYTES = 163840;
constexpr int RTAB_OFF = RING_BYTES;
constexpr int LDSCTL_BYTES = 1024, LDSCTL_OFF = LDS_BYTES - LDSCTL_BYTES, MISC_OFF = LDSCTL_OFF + 320;

#define GAS __attribute__((address_space(1)))
#define LAS __attribute__((address_space(3)))
typedef unsigned short bf16;
typedef unsigned v4u __attribute__((ext_vector_type(4)));
typedef unsigned v2u __attribute__((ext_vector_type(2)));
typedef float f32x4 __attribute__((ext_vector_type(4)));
typedef GAS unsigned gu32;
#define LDS_WAIT() asm volatile("s_waitcnt lgkmcnt(0)" ::: "memory")
#define VM_WAIT() asm volatile("s_waitcnt vmcnt(0)" ::: "memory")
__device__ __forceinline__ unsigned f2bf(float f) { unsigned u = __builtin_bit_cast(unsigned, f); return (u + 0x7fffu + ((u >> 16) & 1u)) >> 16; }
__device__ __forceinline__ unsigned pk2(float lo, float hi) { return f2bf(lo) | (f2bf(hi) << 16); }
__device__ __forceinline__ float bf2f(bf16 b) { return __uint_as_float(((unsigned)b) << 16); }

#define XB_TMO      128
#define XB_XCNT(j)  (256  + 64 * (j))
#define XB_XSUB(j)  (1280 + 64 * (j))
#define XB_XGEN(j)  (2304 + 64 * (j))
#define XB_TOP      3328
#define XB_TOPGEN   3392
#define XCD_BAR_WORDS 3456
#define XB_SPIN_CAP (1u << 20)
__device__ __forceinline__ unsigned xb_ld(unsigned* p)              { return __hip_atomic_load(p, __ATOMIC_RELAXED, __HIP_MEMORY_SCOPE_AGENT); }
__device__ __forceinline__ unsigned xb_add(unsigned* p, unsigned v) { return __hip_atomic_fetch_add(p, v, __ATOMIC_RELAXED, __HIP_MEMORY_SCOPE_AGENT); }
__device__ __forceinline__ unsigned xb_xcc_id() { return (unsigned)__builtin_amdgcn_s_getreg((3 << 11) | 20) & 0xFu; }
#define XB_SPIN(cond, bar) do { unsigned _sp = 0; while (cond) { __builtin_amdgcn_s_sleep(1); \
    if ((++_sp & 255u) == 0u) { if (xb_ld(&(bar)[XB_TMO])) break; if (_sp > XB_SPIN_CAP) { atomicAdd(&(bar)[XB_TMO], 1u); break; } } } } while (0)
struct XcdBarrier { unsigned* bar; unsigned x; volatile LAS unsigned* st; };
__device__ __forceinline__ XcdBarrier xcd_barrier_post(unsigned* bar, volatile LAS unsigned* st) {
    XcdBarrier b; b.bar = bar; b.x = xb_xcc_id(); b.st = st;
    if (threadIdx.x == 0) (void)xb_add(&bar[XB_XCNT(b.x)], 1u);
    return b;
}
__device__ __forceinline__ void xcd_barrier_complete(unsigned* bar, unsigned x, unsigned& nloc, unsigned& nx) {
    const unsigned G = gridDim.x * gridDim.y * gridDim.z;
    unsigned sum, cnt, mine, sp = 0u;
    for (;;) {
        sum = 0u; cnt = 0u; mine = 0u;
#pragma unroll 1
        for (unsigned j = 0; j < 16; ++j) { const unsigned c = xb_ld(&bar[XB_XCNT(j)]); sum += c; cnt += (c > 0u) ? 1u : 0u; mine = (j == x) ? c : mine; }
        if (sum == G) break;
        __builtin_amdgcn_s_sleep(1);
        if ((++sp & 255u) == 0u) { if (xb_ld(&bar[XB_TMO])) break; if (sp > XB_SPIN_CAP) { atomicAdd(&bar[XB_TMO], 1u); break; } }
    }
    nloc = mine > 0u ? mine : 1u; nx = cnt > 0u ? cnt : 1u;
}
__device__ __forceinline__ void xcd_barrier(const XcdBarrier& b, unsigned* barw_in) {
    asm volatile("s_waitcnt vmcnt(0)" ::: "memory");
    __syncthreads();
    if (threadIdx.x == 0) {
        unsigned* bar = barw_in; asm volatile("" : "+s"(bar));
        __builtin_amdgcn_s_waitcnt(0);
        unsigned nloc = b.st[0], nx = b.st[1];
        if (nloc == 0u) { xcd_barrier_complete(bar, b.x, nloc, nx); b.st[0] = nloc; b.st[1] = nx; }
        const unsigned old = xb_add(&bar[XB_XSUB(b.x)], 1u);
        const unsigned gen = old / nloc;
        if (old + 1u == (gen + 1u) * nloc) {
            __builtin_amdgcn_fence(__ATOMIC_RELEASE, "agent");
            asm volatile("s_waitcnt vmcnt(0)" ::: "memory");
            const unsigned og = xb_add(&bar[XB_TOP], 1u);
            const unsigned tg = og / nx;
            if (og + 1u == (tg + 1u) * nx) xb_add(&bar[XB_TOPGEN], 1u);
            else XB_SPIN(xb_ld(&bar[XB_TOPGEN]) == tg, bar);
            __builtin_amdgcn_fence(__ATOMIC_ACQUIRE, "agent");
            xb_add(&bar[XB_XGEN(b.x)], 1u);
            asm volatile("s_waitcnt vmcnt(0)" ::: "memory");
        } else {
            XB_SPIN(xb_ld(&bar[XB_XGEN(b.x)]) == gen, bar);
            __builtin_amdgcn_fence(__ATOMIC_ACQUIRE, "agent");
            asm volatile("s_waitcnt vmcnt(0)" ::: "memory");
        }
    }
    __syncthreads();
}

struct Args {
    const float *x, *p, *g_mix, *w_in, *lb_logits, *g_hg, *conv_w, *w_gate, *b_gate, *g_gla, *w_out, *g_mlp, *w_up, *w_down, *g_ple, *w_pg, *w_pp, *g_final;
    float* out; unsigned char* ws; int ph_lo, ph_hi;
};
struct Frame {
    LAS unsigned char* lds;
    int tid, lane, wave, G, gw, NGW;
};
__device__ __forceinline__ float wave_sum(float v) {
    v += pg8::dpp_get<0xB1>(v); v += pg8::dpp_get<0x4E>(v); v += pg8::dpp_get<0x141>(v); v += pg8::dpp_get<0x140>(v);
    return pg8::sum_xor32(pg8::sum_xor16(v));
}
__device__ __forceinline__ float sigmoidf_(float x) { return __builtin_amdgcn_rcpf(1.0f + __builtin_amdgcn_exp2f(x * -1.4426950408889634f)); }
__device__ __forceinline__ float siluf_(float x) { return x * __builtin_amdgcn_rcpf(1.0f + __builtin_amdgcn_exp2f(x * -1.4426950408889634f)); }

template <bool F8 = false, bool TILED = true>
__device__ __forceinline__ void transpose_item(const float* W, int ldw, int k0, int n0, int ncols, bf16* WT, int K, int nrow0, const float* g, LAS float* scr, int lane) {
    const int r4 = lane >> 4, c4 = lane & 15;
    f32x4 v[16];
#pragma unroll
    for (int i = 0; i < 16; ++i) { const int row = 4 * i + r4; v[i] = (f32x4){0.f, 0.f, 0.f, 0.f}; if (c4 * 4 < ncols) v[i] = *(const f32x4*)(W + (size_t)(k0 + row) * ldw + n0 + c4 * 4); }
#pragma unroll
    for (int i = 0; i < 16; ++i) { const int row = 4 * i + r4; const float gs = (g ? g[k0 + row] : 1.0f) * (F8 ? pg8::F8_WSCALE : 1.0f);
        *(LAS f32x4*)(scr + row * 68 + ((c4 * 4) ^ ((row >> 3) << 2))) = v[i] * gs; }
    LDS_WAIT(); asm volatile("" ::: "memory");
    if constexpr (TILED) {
        const int r = lane >> 2, kp = lane & 3;
#pragma unroll
        for (int j = 0; j < 8; ++j) { const int blk = j >> 2, gq = (j >> 1) & 1, ksub = j & 1, k8 = ksub * 4 + kp, n = blk * 32 + pg8::perm32(16 * gq + r), q = nrow0 + blk * 32 + 16 * gq + r;
            const LAS float* s = scr + (8 * k8) * 68 + (n ^ (k8 << 2));
            if constexpr (F8) {
                v2u o8; o8.x = pg8::cvt_pk_fp8x4(s[0 * 68], s[1 * 68], s[2 * 68], s[3 * 68]); o8.y = pg8::cvt_pk_fp8x4(s[4 * 68], s[5 * 68], s[6 * 68], s[7 * 68]);
                *(GAS v2u*)((unsigned char*)WT + (((size_t)(q >> 4) * (K >> 6) + (k0 >> 6)) << 10) + (q & 15) * 64 + 8 * k8) = o8;
            } else {
                v4u o; o.x = pg8::cvt_pk_bf16(s[0 * 68], s[1 * 68]); o.y = pg8::cvt_pk_bf16(s[2 * 68], s[3 * 68]); o.z = pg8::cvt_pk_bf16(s[4 * 68], s[5 * 68]); o.w = pg8::cvt_pk_bf16(s[6 * 68], s[7 * 68]);
                *(GAS v4u*)(WT + (((size_t)(q >> 4) * (K >> 5) + (k0 >> 5) + ksub) << 9) + (q & 15) * 32 + 8 * kp) = o; } }
    } else {
    const int c = lane & 7;
    #pragma unroll
        for (int j = 0; j < 8; ++j) { const int n = (lane >> 3) + 8 * j; const LAS float* s = scr + (8 * c) * 68 + (n ^ (c << 2));
            if constexpr (F8) {
                v2u o8; o8.x = pg8::cvt_pk_fp8x4(s[0 * 68], s[1 * 68], s[2 * 68], s[3 * 68]); o8.y = pg8::cvt_pk_fp8x4(s[4 * 68], s[5 * 68], s[6 * 68], s[7 * 68]);
                if (n < ncols) *(GAS v2u*)((unsigned char*)WT + (size_t)(nrow0 + n) * K + k0 + 8 * c) = o8; continue; }
            v4u o; o.x = pg8::cvt_pk_bf16(s[0 * 68], s[1 * 68]); o.y = pg8::cvt_pk_bf16(s[2 * 68], s[3 * 68]); o.z = pg8::cvt_pk_bf16(s[4 * 68], s[5 * 68]); o.w = pg8::cvt_pk_bf16(s[6 * 68], s[7 * 68]);
            if (n < ncols) *(GAS v4u*)(WT + (size_t)(nrow0 + n) * K + k0 + 8 * c) = o; }
}
    LDS_WAIT(); asm volatile("" ::: "memory");
}

__device__ __forceinline__ void prologue(const Args& a, Frame& F) {
    LAS float* scr = (LAS float*)(F.lds + RING_OFF + F.wave * 17408);
    constexpr int I_IN = 32 * 112, I_GA = 32, I_OUT = 32 * 32, I_UP = 32 * 128, I_DN = 128 * 32, I_PG = 32 * 32, I_PP = 4 * 32;
    constexpr int I_LAYER = I_IN + I_GA + I_OUT + I_UP + I_DN + I_PG + I_PP;
    for (int it = F.gw; it < DEPTH * I_LAYER; it += F.NGW) {
        const int l = it / I_LAYER; int r = it % I_LAYER;
        unsigned char* wl = a.ws + WS_W + (size_t)l * W_LAYER;
        if (r < I_IN) { const int kb = r / 112, nb = r % 112; transpose_item(a.w_in + (size_t)l * D * INW, INW, 64 * kb, 64 * nb, 64, (bf16*)(wl + WO_IN), D, 64 * nb, a.g_mix + l * D, scr, F.lane); continue; } r -= I_IN;
        if (r < I_GA) { transpose_item<false, false>(a.w_in + (size_t)l * D * INW, INW, 64 * r, ZW, 16, (bf16*)(wl + WO_GA), D, 0, a.g_mix + l * D, scr, F.lane); continue; } r -= I_GA;
        if (r < I_OUT) { const int kb = r / 32, nb = r % 32; transpose_item(a.w_out + (size_t)l * D * D, D, 64 * kb, 64 * nb, 64, (bf16*)(wl + WO_OUT), D, 64 * nb, nullptr, scr, F.lane); continue; } r -= I_OUT;
        if (r < I_UP) { const int kb = r / 128, nb = r % 128; transpose_item(a.w_up + (size_t)l * D * FF, FF, 64 * kb, 64 * nb, 64, (bf16*)(wl + WO_UP), D, 64 * nb, a.g_mlp + l * D, scr, F.lane); continue; } r -= I_UP;
        if (r < I_DN) { const int kb = r / 32, nb = r % 32; transpose_item(a.w_down + (size_t)l * FF * D, D, 64 * kb, 64 * nb, 64, (bf16*)(wl + WO_DN), FF, 64 * nb, nullptr, scr, F.lane); continue; } r -= I_DN;
        if (r < I_PG) { const int kb = r / 32, nb = r % 32; transpose_item<true>(a.w_pg + (size_t)l * D * D, D, 64 * kb, 64 * nb, 64, (bf16*)(wl + WO_PG), D, 64 * nb, a.g_ple + l * D, scr, F.lane); continue; } r -= I_PG;
        { const int kb = r / 32, nb = r % 32; transpose_item(a.w_pp + (size_t)l * PLE * D, D, 64 * kb, 64 * nb, 64, (bf16*)(wl + WO_PP), PLE, 64 * nb, nullptr, scr, F.lane); }
    }
    bf16* hb = (bf16*)(a.ws + WS_HBA); float* st = (float*)(a.ws + WS_STATS);
    for (int m0 = F.gw; m0 < M; m0 += 2 * F.NGW) {
        f32x4 v[2][8];
#pragma unroll
        for (int r = 0; r < 2; ++r) { const int m = m0 + r * F.NGW; if (m < M) { const GAS f32x4* xr = (const GAS f32x4*)(a.x + (size_t)m * D) + F.lane;
#pragma unroll
            for (int j = 0; j < 8; ++j) v[r][j] = xr[64 * j]; } }
#pragma unroll
        for (int r = 0; r < 2; ++r) { const int m = m0 + r * F.NGW; if (m < M) { float s = 0.f;
#pragma unroll
            for (int j = 0; j < 8; ++j) { const f32x4 q = v[r][j]; s += (q.x * q.x + q.y * q.y) + (q.z * q.z + q.w * q.w); v2u w; w.x = pg8::cvt_pk_bf16(q.x, q.y); w.y = pg8::cvt_pk_bf16(q.z, q.w); *(GAS v2u*)(hb + pg8::tile_rc(m, 4 * (F.lane + 64 * j), D)) = w; }
            s = wave_sum(s);
            if (F.lane < 32) st[(size_t)m * 32 + F.lane] = (F.lane == 0) ? s : 0.f; } }
    }
}

__device__ __forceinline__ void ga_phase(const Args& a, Frame& F, const bf16* hb, const bf16* wga, const float* stats, float* GA) {
    typedef short bf16x8g __attribute__((ext_vector_type(8)));
    const int fr = F.lane & 15, fq = F.lane >> 4, tl = F.wave & 3, kh = F.wave >> 2;
    LAS f32x4* part = (LAS f32x4*)(F.lds);
    for (int t = blockIdx.x * 4 + tl; t < M / 16; t += F.G * 4) {
        const int row0 = t * 16;
        const bf16* ap = hb + pg8::tile_rc(row0 + fr, kh * (D / 2) + fq * 8, D);
        const bf16* bp = wga + (size_t)fr * D + kh * (D / 2) + fq * 8;
        f32x4 acc = {0.f, 0.f, 0.f, 0.f};
#pragma unroll 8
        for (int kk = 0; kk < D / 64; ++kk) {
            const bf16x8g av = *(const bf16x8g*)(ap + kk * 512), bv = *(const bf16x8g*)(bp + kk * 32);
            acc = __builtin_amdgcn_mfma_f32_16x16x32_bf16(av, bv, acc, 0, 0, 0); }
        if (kh == 1) part[tl * 64 + F.lane] = acc;
        __syncthreads();
        if (kh == 0) {
            acc = acc + part[tl * 64 + F.lane];
            const f32x4* sp = (const f32x4*)(stats + (size_t)(row0 + fr) * 32 + fq * 8); const f32x4 s0 = sp[0], s1 = sp[1];
            float sv = ((s0[0] + s0[1]) + (s0[2] + s0[3])) + ((s1[0] + s1[1]) + (s1[2] + s1[3]));
            sv = pg8::sum_xor16(sv); sv = pg8::sum_xor32(sv);
            const float rstd = __builtin_amdgcn_rsqf(sv * (1.0f / D) + EPS);
#pragma unroll
            for (int i = 0; i < 4; ++i) GA[(size_t)(row0 + 4 * fq + i) * GRANK + fr] = acc[i] * __builtin_bit_cast(float, __builtin_amdgcn_ds_bpermute((4 * fq + i) * 4, __builtin_bit_cast(int, rstd)));
        }
        __syncthreads();
    }
}

__device__ __forceinline__ void pb_phase(const Args& a, Frame& F, int l) {
    const GAS f32x4* src = (const GAS f32x4*)(a.p + (size_t)l * M * PLE); GAS v2u* dst = (GAS v2u*)(a.ws + WS_PB);
    const size_t n4 = (size_t)M * PLE / 4;
    const size_t stride = (size_t)F.G * 512;
    for (size_t i0 = (size_t)blockIdx.x * 512 + F.tid; i0 < n4; i0 += 8 * stride) {
        f32x4 v[8];
#pragma unroll
        for (int j = 0; j < 8; ++j) { const size_t i = i0 + j * stride; v[j] = (i < n4) ? src[i] : (f32x4){0.f, 0.f, 0.f, 0.f}; }
#pragma unroll
        for (int j = 0; j < 8; ++j) { const size_t i = i0 + j * stride; if (i < n4) { v2u w; w.x = pg8::cvt_pk_bf16(v[j].x, v[j].y); w.y = pg8::cvt_pk_bf16(v[j].z, v[j].w); dst[i] = w; } }
    }
}

namespace mx {
typedef short bf16x8 __attribute__((ext_vector_type(8)));
typedef float f32x2v __attribute__((ext_vector_type(2)));
constexpr int AR = 0;
constexpr int RS128 = 272, RS256 = 528, TS = 144;
constexpr int RW128 = 256, RW256 = 512;
constexpr int A_RAWQ = 0, A_RAWK = 17408, A_RAWV = 34816;
constexpr int A_GAT = 69632;
constexpr int A_QT = 73728, A_KT = 91136, A_KDT = A_QT, A_VT = 108544, A_P = 145408;
constexpr int A_TOT = 154624, A_RED = 156672, A_DV = 158720, A_EMV = 159232, A_END = 159744;
constexpr int A_YST = A_QT;
static_assert(AR + A_END <= LDSCTL_OFF, "mixer arena vs LDS control words");
constexpr int E_TOTAL = 8 * 128 * 128 + 4 * 256 * 128;
constexpr int SUPER = 4, NSUPER = NCHUNK / SUPER;
constexpr float XCL = 100.0f;

template <int DV> __device__ __forceinline__ size_t st_off(int v, int k4, int fq) { return ((size_t)((2 * k4 + (fq >> 1)) * DV + v) << 4) + 8 * (fq & 1); }
__device__ __forceinline__ float clampx(float x) { return fminf(fmaxf(x, -XCL), XCL); }
__device__ __forceinline__ void wg_sync() { asm volatile("s_waitcnt vmcnt(0) lgkmcnt(0)" ::: "memory"); __builtin_amdgcn_s_barrier(); asm volatile("" ::: "memory"); }
__device__ __forceinline__ void wg_sync_lds() { asm volatile("s_waitcnt lgkmcnt(0)" ::: "memory"); __builtin_amdgcn_s_barrier(); asm volatile("" ::: "memory"); }
__device__ __forceinline__ unsigned pk(float lo, float hi) { return pg8::cvt_pk_bf16(lo, hi); }

template <bool GLA, bool M3>
__device__ __forceinline__ void raw_issue(LAS unsigned char* ar, const int wave, const int lane, const bf16* Z, const float* GAg, const unsigned char* zero_page, const int t0, const int hu, const int buf) {
    const int oK = (!GLA && !M3 && buf) ? A_RAWQ : A_RAWK, oV = A_RAWV + ((!GLA && !M3 && buf) ? 17408 : 0);
#define MX_DMA(src, dstoff) __builtin_amdgcn_global_load_lds((const unsigned*)(src), (LAS unsigned*)(ar + (dstoff)), 16, 0, 0)
    if (!GLA) {
#pragma unroll
        for (int i = 0; i < 2; ++i) { const int pi = wave + 8 * i, row = 4 * pi + (lane >> 4), pc = lane & 15;
            const bf16* src = Z + pg8::tile_rc(t0 + row, hu * 128 + pc * 8, ZW);
            if (M3) MX_DMA(src + ZC_HQ * 16, A_RAWQ + pi * 1024);
            MX_DMA(src + ZC_HF * 16, oK + pi * 1024);
            MX_DMA(src + ZC_HI * 16, oV + pi * 1024); }
    } else {
#pragma unroll
        for (int i = 0; i < 3; ++i) { const int pi = wave + 8 * i;
            if (pi < 17) { int row = 4 * pi + (lane >> 4); row = row < 67 ? row : 66; const int pc = lane & 15, t = t0 - 3 + row;
                const unsigned char* base = (t < 0) ? (zero_page + pc * 16) : (const unsigned char*)(Z + pg8::tile_rc(t < 0 ? 0 : t, hu * 128 + pc * 8, ZW));
                const unsigned char* sq = (t < 0) ? base : base + ZC_GQ * 32; const unsigned char* sk = (t < 0) ? base : base + ZC_GK * 32;
                if (M3) MX_DMA(sq, A_RAWQ + pi * 1024);
                MX_DMA(sk, A_RAWK + pi * 1024); } }
#pragma unroll
        for (int i = 0; i < 5; ++i) { const int pi = wave + 8 * i;
            if (pi < 34) { int row = 2 * pi + (lane >> 5); row = row < 67 ? row : 66; const int pc = lane & 31, t = t0 - 3 + row;
                const unsigned char* sv = (t < 0) ? (zero_page + pc * 16) : (const unsigned char*)(Z + pg8::tile_rc(t < 0 ? 0 : t, ZC_GV + hu * 256 + pc * 8, ZW));
                MX_DMA(sv, A_RAWV + pi * 1024); } }
        if (wave < 4) MX_DMA(GAg + (size_t)t0 * GRANK + wave * 256 + lane * 4, A_GAT + wave * 1024);
    }
#undef MX_DMA
}

template <bool GLA, bool M3> struct Carry {
    static constexpr int DV = GLA ? 256 : 128, NVT = DV / 128;
    f32x4 acc[M3 ? 1 : DV / 16];
    v4u S[M3 ? NVT : 1][4];
    float dsum, lb;
};

template <bool GLA, bool M3>
__device__ __forceinline__ void mix_step(const Args& a, LAS unsigned char* ar, const int wave, const int lane, const int l, const int chunk, const int hu, const int j4,
                                         const bool has_next, const int nchunk, const int nhu,
                                         const bf16* Z, const float* GAg, const unsigned char* zero_page, bf16* SB, bf16* SSUP, float* DSUP, bf16* Y, Carry<GLA, M3>& C) {
    const int tid = wave * 64 + lane, t0 = chunk * CHUNK;
    constexpr int DV = GLA ? 256 : 128, NVT = DV / 128;
    const int c = tid & 127, seg = tid >> 7;
    const int fr = lane & 15, fq = lane >> 4;
    const int chq = GLA ? (1024 + hu * 128) : (hu * 128);
    const size_t eoff = GLA ? (131072 + hu * 32768) : (hu * 16384);
    const size_t sbase = (size_t)chunk * E_TOTAL + eoff, supbase = (size_t)(chunk / SUPER) * E_TOTAL + eoff;
    float ck0 = 0.f, ck1 = 0.f, ck2 = 0.f, ck3 = 0.f, cq0 = 0.f, cq1 = 0.f, cq2 = 0.f, cq3 = 0.f, bgv = 0.f, wg[GRANK];
    if (GLA) {
        const float* cwk = a.conv_w + (size_t)l * 4 * CONVC + 512 + hu * 128 + c; ck0 = cwk[0]; ck1 = cwk[CONVC]; ck2 = cwk[2 * CONVC]; ck3 = cwk[3 * CONVC];
        if (M3) { const float* cwq = a.conv_w + (size_t)l * 4 * CONVC + hu * 128 + c; cq0 = cwq[0]; cq1 = cwq[CONVC]; cq2 = cwq[2 * CONVC]; cq3 = cwq[3 * CONVC]; }
        const float* wgp = a.w_gate + (size_t)l * GRANK * GKW + hu * 128 + c; bgv = a.b_gate[(size_t)l * GKW + hu * 128 + c];
#pragma unroll
        for (int r = 0; r < GRANK; ++r) wg[r] = wgp[r * GKW];
    }
    wg_sync();
    constexpr bool DBUF = !GLA && !M3;
    const int oK = (DBUF && (j4 & 1)) ? A_RAWQ : A_RAWK, oV = A_RAWV + ((DBUF && (j4 & 1)) ? 17408 : 0);
    if (DBUF && has_next) raw_issue<GLA, M3>(ar, wave, lane, Z, GAg, zero_page, nchunk * CHUNK, nhu, (j4 + 1) & 1);
    constexpr bool HOIST = M3 && !GLA;
    v4u dsl[M3 ? NVT : 1][4]; v2u gate[M3 ? NVT : 1][4];
    const bf16* dsrc = (j4 < SUPER - 1) ? (SB + sbase) : (const bf16*)zero_page;
    const int gcol0 = GLA ? (ZC_GR + hu * 256) : (ZC_HG + hu * 128);
    if (HOIST) {
#pragma unroll
        for (int jv = 0; jv < NVT; ++jv) {
#pragma unroll
            for (int k4 = 0; k4 < 4; ++k4) dsl[jv][k4] = *(const v4u*)(dsrc + st_off<DV>((wave + 8 * jv) * 16 + fr, k4, fq));
#pragma unroll
            for (int tt = 0; tt < 4; ++tt) gate[jv][tt] = *(const v2u*)(Z + pg8::tile_rc(t0 + tt * 16 + fr, gcol0 + (wave + 8 * jv) * 16 + 4 * fq, ZW)); }
    }
    {
        const int sg = tid >> 7;
#pragma unroll
        for (int j = 0; j < NVT; ++j) { const int v = (tid & 127) + 128 * j; unsigned w[8];
            if (!GLA) {
#pragma unroll
                for (int i = 0; i < 8; ++i) { const unsigned lo = *(const LAS bf16*)(ar + oV + (sg * 16 + 2 * i) * RW128 + v * 2), hi = *(const LAS bf16*)(ar + oV + (sg * 16 + 2 * i + 1) * RW128 + v * 2); w[i] = lo | (hi << 16); }
            } else {
                const float* cw = a.conv_w + (size_t)l * 4 * CONVC + 1024 + hu * 256 + v; const float w0 = cw[0], w1 = cw[CONVC], w2 = cw[2 * CONVC], w3 = cw[3 * CONVC];
                float x0 = bf2f(*(const LAS bf16*)(ar + A_RAWV + (sg * 16 + 0) * RW256 + v * 2)), x1 = bf2f(*(const LAS bf16*)(ar + A_RAWV + (sg * 16 + 1) * RW256 + v * 2)), x2 = bf2f(*(const LAS bf16*)(ar + A_RAWV + (sg * 16 + 2) * RW256 + v * 2));
                float o[16];
#pragma unroll
                for (int i = 0; i < 16; ++i) { const float x3 = bf2f(*(const LAS bf16*)(ar + A_RAWV + (sg * 16 + i + 3) * RW256 + v * 2)); o[i] = siluf_(w0 * x0 + w1 * x1 + w2 * x2 + w3 * x3); x0 = x1; x1 = x2; x2 = x3; }
#pragma unroll
                for (int i = 0; i < 8; ++i) w[i] = pk(o[2 * i], o[2 * i + 1]);
            }
            v4u wa = {w[0], w[1], w[2], w[3]}, wb = {w[4], w[5], w[6], w[7]};
            *(LAS v4u*)(ar + A_VT + v * TS + sg * 32) = wa; *(LAS v4u*)(ar + A_VT + v * TS + sg * 32 + 16) = wb; }
    }
    {
        float lf[16], kk[16], qq[16];
        if (!GLA) {
            const float lb = C.lb;
#pragma unroll
            for (int i = 0; i < 16; ++i) { const int lt = seg * 16 + i; const float zf = bf2f(*(const LAS bf16*)(ar + oK + lt * RW128 + c * 2));
                const float en = __builtin_amdgcn_exp2f(zf * -1.4426950408889634f), sg = __builtin_amdgcn_rcpf(1.0f + en), f = lb + (1.0f - lb) * sg;
                lf[i] = __builtin_amdgcn_logf(f); kk[i] = (1.0f - lb) * (en * sg);
                if (M3) qq[i] = bf2f(*(const LAS bf16*)(ar + A_RAWQ + lt * RW128 + c * 2)); }
        } else {
            float xk0 = bf2f(*(const LAS bf16*)(ar + A_RAWK + (seg * 16 + 0) * RW128 + c * 2)), xk1 = bf2f(*(const LAS bf16*)(ar + A_RAWK + (seg * 16 + 1) * RW128 + c * 2)), xk2 = bf2f(*(const LAS bf16*)(ar + A_RAWK + (seg * 16 + 2) * RW128 + c * 2));
            float xq0 = 0.f, xq1 = 0.f, xq2 = 0.f;
            if (M3) { xq0 = bf2f(*(const LAS bf16*)(ar + A_RAWQ + (seg * 16 + 0) * RW128 + c * 2)); xq1 = bf2f(*(const LAS bf16*)(ar + A_RAWQ + (seg * 16 + 1) * RW128 + c * 2)); xq2 = bf2f(*(const LAS bf16*)(ar + A_RAWQ + (seg * 16 + 2) * RW128 + c * 2)); }
#pragma unroll
            for (int i = 0; i < 16; ++i) { const int lt = seg * 16 + i;
                const float xk3 = bf2f(*(const LAS bf16*)(ar + A_RAWK + (lt + 3) * RW128 + c * 2)); kk[i] = siluf_(ck0 * xk0 + ck1 * xk1 + ck2 * xk2 + ck3 * xk3); xk0 = xk1; xk1 = xk2; xk2 = xk3;
                if (M3) { const float xq3 = bf2f(*(const LAS bf16*)(ar + A_RAWQ + (lt + 3) * RW128 + c * 2)); qq[i] = siluf_(cq0 * xq0 + cq1 * xq1 + cq2 * xq2 + cq3 * xq3) * 0.08838834764831845f; xq0 = xq1; xq1 = xq2; xq2 = xq3; }
                float xg = bgv; const LAS f32x4* gr = (const LAS f32x4*)(ar + A_GAT + lt * 64);
#pragma unroll
                for (int r4 = 0; r4 < 4; ++r4) { const f32x4 gv = gr[r4]; xg += gv[0] * wg[4 * r4] + gv[1] * wg[4 * r4 + 1] + gv[2] * wg[4 * r4 + 2] + gv[3] * wg[4 * r4 + 3]; }
                lf[i] = (fminf(xg, 0.f) * 1.4426950408889634f - __builtin_amdgcn_logf(1.0f + __builtin_amdgcn_exp2f(fabsf(xg) * -1.4426950408889634f))) * (1.0f / 16.0f); }
        }
#pragma unroll
        for (int i = 1; i < 16; ++i) lf[i] += lf[i - 1];
        ((LAS float*)(ar + A_TOT))[seg * 128 + c] = lf[15];
        wg_sync_lds();
        if (!DBUF && has_next) raw_issue<GLA, M3>(ar, wave, lane, Z, GAg, zero_page, nchunk * CHUNK, nhu, 0);
        const float t0s = ((const LAS float*)(ar + A_TOT))[c], t1s = ((const LAS float*)(ar + A_TOT))[128 + c], t2s = ((const LAS float*)(ar + A_TOT))[256 + c], t3s = ((const LAS float*)(ar + A_TOT))[384 + c];
        const float mref = t0s + t1s, blast = (t0s + t1s) + (t2s + t3s);
        const float off = (seg == 0) ? 0.f : (seg == 1) ? t0s : (seg == 2) ? (t0s + t1s) : ((t0s + t1s) + t2s);
        if (seg == 0) { ((LAS float*)(ar + A_DV))[c] = __builtin_amdgcn_exp2f(blast); if (M3) ((LAS float*)(ar + A_EMV))[c] = __builtin_amdgcn_exp2f(mref); }
        if (M3) {
#pragma unroll
            for (int i = 0; i < 16; ++i) { const int lt = seg * 16 + i; const float b = off + lf[i];
                const unsigned qk = pk(qq[i] * __builtin_amdgcn_exp2f(fminf(b - mref, XCL)), kk[i] * __builtin_amdgcn_exp2f(fminf(mref - b, XCL)));
                *(LAS bf16*)(ar + A_QT + lt * RS128 + c * 2) = (bf16)(qk & 0xffffu);
                *(LAS bf16*)(ar + A_KT + lt * RS128 + c * 2) = (bf16)(qk >> 16); }
        } else {
            unsigned w[8];
#pragma unroll
            for (int i = 0; i < 8; ++i) { const float b0 = off + lf[2 * i], b1 = off + lf[2 * i + 1]; w[i] = pk(kk[2 * i] * __builtin_amdgcn_exp2f(blast - b0), kk[2 * i + 1] * __builtin_amdgcn_exp2f(blast - b1)); }
            v4u wa = {w[0], w[1], w[2], w[3]}, wb = {w[4], w[5], w[6], w[7]};
            *(LAS v4u*)(ar + A_KDT + c * TS + seg * 32) = wa; *(LAS v4u*)(ar + A_KDT + c * TS + seg * 32 + 16) = wb;
            if (seg == 0) { C.dsum += blast; if (j4 == SUPER - 1) DSUP[(size_t)(chunk / SUPER) * 1536 + chq + c] = __builtin_amdgcn_exp2f(C.dsum); }
        }
    }
    wg_sync_lds();
    if (!M3) {
        const bf16x8 a0 = *(const LAS bf16x8*)(ar + A_KDT + (wave * 16 + fr) * TS + fq * 16), a1 = *(const LAS bf16x8*)(ar + A_KDT + (wave * 16 + fr) * TS + fq * 16 + 64);
        const f32x4 dv = *(const LAS f32x4*)(ar + A_DV + (wave * 16 + 4 * fq) * 4);
        const size_t orow = ((size_t)(wave * DV + (fq & 1) * 16 + fr) << 4) + 4 * (fq & ~1);
#pragma unroll
        for (int vt = 0; vt < DV / 16; vt += 2) {
            f32x4 t2[2];
#pragma unroll
            for (int h = 0; h < 2; ++h) {
                const bf16x8 b0 = *(const LAS bf16x8*)(ar + A_VT + ((vt + h) * 16 + fr) * TS + fq * 16), b1 = *(const LAS bf16x8*)(ar + A_VT + ((vt + h) * 16 + fr) * TS + fq * 16 + 64);
                f32x4 t = {0.f, 0.f, 0.f, 0.f};
                t = __builtin_amdgcn_mfma_f32_16x16x32_bf16(a0, b0, t, 0, 0, 0);
                t = __builtin_amdgcn_mfma_f32_16x16x32_bf16(a1, b1, t, 0, 0, 0);
                t2[h] = t; }
            if (j4 < SUPER - 1) {
                const auto r0 = __builtin_amdgcn_permlane16_swap(pk(t2[0][0], t2[0][1]), pk(t2[1][0], t2[1][1]), false, false);
                const auto r1 = __builtin_amdgcn_permlane16_swap(pk(t2[0][2], t2[0][3]), pk(t2[1][2], t2[1][3]), false, false);
                v4u o; o.x = (unsigned)r0[0]; o.y = (unsigned)r1[0]; o.z = (unsigned)r0[1]; o.w = (unsigned)r1[1];
                *(v4u*)(SB + sbase + (size_t)vt * 16 * 16 + orow) = o; }
            C.acc[vt] = C.acc[vt] * dv + t2[0]; C.acc[vt + 1] = C.acc[vt + 1] * dv + t2[1];
            if (j4 == SUPER - 1) {
                const auto r0 = __builtin_amdgcn_permlane16_swap(pk(C.acc[vt][0], C.acc[vt][1]), pk(C.acc[vt + 1][0], C.acc[vt + 1][1]), false, false);
                const auto r1 = __builtin_amdgcn_permlane16_swap(pk(C.acc[vt][2], C.acc[vt][3]), pk(C.acc[vt + 1][2], C.acc[vt + 1][3]), false, false);
                v4u o; o.x = (unsigned)r0[0]; o.y = (unsigned)r1[0]; o.z = (unsigned)r0[1]; o.w = (unsigned)r1[1];
                *(v4u*)(SSUP + supbase + (size_t)vt * 16 * 16 + orow) = o; } }
    } else {
        {
            const int tt = wave & 3;
#pragma unroll
            for (int j = 0; j < 2; ++j) { const int st = (wave >> 2) * 2 + j;
                f32x4 acc = {0.f, 0.f, 0.f, 0.f};
#pragma unroll
                for (int k4 = 0; k4 < 4; ++k4) { const bf16x8 ak = *(const LAS bf16x8*)(ar + A_KT + (st * 16 + fr) * RS128 + fq * 16 + k4 * 64), bq = *(const LAS bf16x8*)(ar + A_QT + (tt * 16 + fr) * RS128 + fq * 16 + k4 * 64);
                    acc = __builtin_amdgcn_mfma_f32_16x16x32_bf16(ak, bq, acc, 0, 0, 0); }
#pragma unroll
                for (int i = 0; i < 4; ++i) acc[i] = (st * 16 + 4 * fq + i <= tt * 16 + fr) ? acc[i] : 0.f;
                v2u o; o.x = pk(acc[0], acc[1]); o.y = pk(acc[2], acc[3]);
                *(LAS v2u*)(ar + A_P + (tt * 16 + fr) * TS + (st * 16 + 4 * fq) * 2) = o; }
        }
        if (!HOIST) {
#pragma unroll
            for (int jv = 0; jv < NVT; ++jv)
#pragma unroll
                for (int tt = 0; tt < 4; ++tt) gate[jv][tt] = *(const v2u*)(Z + pg8::tile_rc(t0 + tt * 16 + fr, gcol0 + (wave + 8 * jv) * 16 + 4 * fq, ZW));
        }
        wg_sync_lds();
        f32x4 oacc[NVT][4];
#pragma unroll
        for (int jv = 0; jv < NVT; ++jv) { const int vt = wave + 8 * jv;
            const bf16x8 va0 = *(const LAS bf16x8*)(ar + A_VT + (vt * 16 + fr) * TS + fq * 16), va1 = *(const LAS bf16x8*)(ar + A_VT + (vt * 16 + fr) * TS + fq * 16 + 64);
            bf16x8 sa[4];
            if (!HOIST) {
#pragma unroll
                for (int k4 = 0; k4 < 4; ++k4) dsl[jv][k4] = *(const v4u*)(dsrc + st_off<DV>(vt * 16 + fr, k4, fq));
            }
#pragma unroll
            for (int k4 = 0; k4 < 4; ++k4) { const f32x4 e0 = *(const LAS f32x4*)(ar + A_EMV + (k4 * 32 + fq * 8) * 4), e1 = *(const LAS f32x4*)(ar + A_EMV + (k4 * 32 + fq * 8 + 4) * 4);
                const v4u sp = C.S[jv][k4]; v4u w;
                w.x = pk(pg8::bf_lo(sp.x) * e0[0], pg8::bf_hi(sp.x) * e0[1]); w.y = pk(pg8::bf_lo(sp.y) * e0[2], pg8::bf_hi(sp.y) * e0[3]);
                w.z = pk(pg8::bf_lo(sp.z) * e1[0], pg8::bf_hi(sp.z) * e1[1]); w.w = pk(pg8::bf_lo(sp.w) * e1[2], pg8::bf_hi(sp.w) * e1[3]);
                sa[k4] = __builtin_bit_cast(bf16x8, w); }
#pragma unroll
            for (int tt = 0; tt < 4; ++tt) { f32x4 acc = {0.f, 0.f, 0.f, 0.f};
                const bf16x8 p0 = *(const LAS bf16x8*)(ar + A_P + (tt * 16 + fr) * TS + fq * 16);
                acc = __builtin_amdgcn_mfma_f32_16x16x32_bf16(va0, p0, acc, 0, 0, 0);
                if (tt >= 2) { const bf16x8 p1 = *(const LAS bf16x8*)(ar + A_P + (tt * 16 + fr) * TS + fq * 16 + 64); acc = __builtin_amdgcn_mfma_f32_16x16x32_bf16(va1, p1, acc, 0, 0, 0); }
#pragma unroll
                for (int k4 = 0; k4 < 4; ++k4) { const bf16x8 bq = *(const LAS bf16x8*)(ar + A_QT + (tt * 16 + fr) * RS128 + fq * 16 + k4 * 64); acc = __builtin_amdgcn_mfma_f32_16x16x32_bf16(sa[k4], bq, acc, 0, 0, 0); }
                oacc[jv][tt] = acc; }
            {
#pragma unroll
                for (int k4 = 0; k4 < 4; ++k4) { const f32x4 d0 = *(const LAS f32x4*)(ar + A_DV + (k4 * 32 + fq * 8) * 4), d1 = *(const LAS f32x4*)(ar + A_DV + (k4 * 32 + fq * 8 + 4) * 4);
                    const v4u sp = C.S[jv][k4], dl = dsl[jv][k4]; v4u w;
                    w.x = pk(pg8::bf_lo(sp.x) * d0[0] + pg8::bf_lo(dl.x), pg8::bf_hi(sp.x) * d0[1] + pg8::bf_hi(dl.x)); w.y = pk(pg8::bf_lo(sp.y) * d0[2] + pg8::bf_lo(dl.y), pg8::bf_hi(sp.y) * d0[3] + pg8::bf_hi(dl.y));
                    w.z = pk(pg8::bf_lo(sp.z) * d1[0] + pg8::bf_lo(dl.z), pg8::bf_hi(sp.z) * d1[1] + pg8::bf_hi(dl.z)); w.w = pk(pg8::bf_lo(sp.w) * d1[2] + pg8::bf_lo(dl.w), pg8::bf_hi(sp.w) * d1[3] + pg8::bf_hi(dl.w));
                    C.S[jv][k4] = w; }
            }
        }
#pragma unroll
        for (int tt = 0; tt < 4; ++tt) { float ss = 0.f;
#pragma unroll
            for (int jv = 0; jv < NVT; ++jv) ss += (oacc[jv][tt][0] * oacc[jv][tt][0] + oacc[jv][tt][1] * oacc[jv][tt][1]) + (oacc[jv][tt][2] * oacc[jv][tt][2] + oacc[jv][tt][3] * oacc[jv][tt][3]);
            ss = pg8::sum_xor16(ss); ss = pg8::sum_xor32(ss);
            if (fq == 0) ((LAS float*)(ar + A_RED))[(tt * 16 + fr) * 8 + wave] = ss; }
        wg_sync_lds();
        const float* gn = GLA ? (a.g_gla + (size_t)l * GLAW + hu * 256) : (a.g_hg + (size_t)l * HGW + hu * 128);
#pragma unroll
        for (int tt = 0; tt < 4; ++tt) { const int t = tt * 16 + fr;
            const f32x4 r0 = *(const LAS f32x4*)(ar + A_RED + t * 32), r1 = *(const LAS f32x4*)(ar + A_RED + t * 32 + 16);
            const float ms = (((r0[0] + r0[1]) + (r0[2] + r0[3])) + ((r1[0] + r1[1]) + (r1[2] + r1[3]))) * (1.0f / DV);
            const float rstd = __builtin_amdgcn_rsqf(ms + EPS);
#pragma unroll
            for (int jv = 0; jv < NVT; ++jv) { const int v = (wave + 8 * jv) * 16 + 4 * fq;
                const f32x4 g4 = *(const f32x4*)(gn + v); const v2u gw = gate[jv][tt];
                const float y0 = oacc[jv][tt][0] * rstd * g4[0] * siluf_(pg8::bf_lo(gw.x)), y1 = oacc[jv][tt][1] * rstd * g4[1] * siluf_(pg8::bf_hi(gw.x));
                const float y2 = oacc[jv][tt][2] * rstd * g4[2] * siluf_(pg8::bf_lo(gw.y)), y3 = oacc[jv][tt][3] * rstd * g4[3] * siluf_(pg8::bf_hi(gw.y));
                v2u o; o.x = pk(y0, y1); o.y = pk(y2, y3);
                *(LAS v2u*)(ar + A_YST + t * (GLA ? RS256 : RS128) + v * 2) = o; } }
        wg_sync_lds();
        {
            constexpr int PPR = DV / 8;
            const int ycol0 = GLA ? (1024 + hu * 256) : (hu * 128);
#pragma unroll
            for (int i = 0; i < (64 * PPR) / 512; ++i) { const int sidx = wave + 8 * i, rg = sidx / (DV / 32), scol = sidx % (DV / 32), r = rg * 16 + (lane >> 2), cc = scol * 32 + (lane & 3) * 8;
                *(v4u*)(Y + pg8::tile_rc(t0 + r, ycol0 + cc, 2048)) = *(const LAS v4u*)(ar + A_YST + r * (GLA ? RS256 : RS128) + cc * 2); }
        }
    }
}

template <bool GLA, bool M3>
__device__ __forceinline__ void mix_head(const Args& a, LAS unsigned char* ar, const int wave, const int l, const int sc, const int hu, const bf16* Z, const float* GAg, const unsigned char* zero_page, bf16* SB, bf16* SSUP, float* DSUP, bf16* Y) {
    constexpr int DV = GLA ? 256 : 128, NVT = DV / 128;
    Carry<GLA, M3> C; C.dsum = 0.f; C.lb = 0.f;
    {
        const int lane = pg8::fresh_lane(), tid = wave * 64 + lane, fr = lane & 15, fq = lane >> 4;
        raw_issue<GLA, M3>(ar, wave, lane, Z, GAg, zero_page, sc * SUPER * CHUNK, hu, 0);
        if (!GLA) { const int ch = hu * 128 + (tid & 127); float lg[DEPTH], mxv = -1e30f;
#pragma unroll
            for (int j = 0; j < DEPTH; ++j) { lg[j] = a.lb_logits[j * HGW + ch]; mxv = fmaxf(mxv, lg[j]); }
            float den = 0.f, num = 0.f;
#pragma unroll
            for (int j = 0; j < DEPTH; ++j) { const float e = __expf(lg[j] - mxv); den += e; if (j >= 1 && j <= l) num += e; }
            C.lb = num / den; }
        if (M3) {
            const size_t supbase = (size_t)sc * E_TOTAL + (GLA ? (131072 + hu * 32768) : (hu * 16384));
#pragma unroll
            for (int jv = 0; jv < NVT; ++jv)
#pragma unroll
                for (int k4 = 0; k4 < 4; ++k4) C.S[jv][k4] = *(const v4u*)(SSUP + supbase + st_off<DV>((wave + 8 * jv) * 16 + fr, k4, fq));
        } else {
#pragma unroll
            for (int vt = 0; vt < DV / 16; ++vt) C.acc[vt] = (f32x4){0.f, 0.f, 0.f, 0.f};
        }
    }
#pragma unroll 1
    for (int j = 0; j < SUPER; ++j) { const int lane = pg8::fresh_lane();
        mix_step<GLA, M3>(a, ar, wave, lane, l, sc * SUPER + j, hu, j, j + 1 < SUPER, sc * SUPER + j + 1, hu, Z, GAg, zero_page, SB, SSUP, DSUP, Y, C); }
    wg_sync();
}
template <bool M3>
__device__ __forceinline__ void mix_phase(const Args& a, LAS unsigned char* lds, const int wave, const int l, const bf16* Z, const float* GAg, bf16* SB, bf16* SSUP, float* DSUP, bf16* Y) {
    LAS unsigned char* ar = lds + AR;
    const unsigned char* zero_page = a.ws + WS_CTL + 512 * 1024;
    for (int w = blockIdx.x; w < NSUPER * 4; w += gridDim.x) {
        const int sc = w >> 2, s = w & 3;
#pragma unroll 1
        for (int k = 0; k < 3; ++k) { int which = k + (w % 3); which = which >= 3 ? which - 3 : which;
            if (which == 2) mix_head<true, M3>(a, ar, wave, l, sc, s, Z, GAg, zero_page, SB, SSUP, DSUP, Y);
            else mix_head<false, M3>(a, ar, wave, l, sc, 2 * s + which, Z, GAg, zero_page, SB, SSUP, DSUP, Y); }
    }
}

__device__ __forceinline__ void scan_phase(const int wave, bf16* SSUP, const float* DSUP) {
    const int lane = pg8::fresh_lane(), tid = wave * 64 + lane;
    for (int e2 = blockIdx.x * 512 + tid; e2 < E_TOTAL / 2; e2 += gridDim.x * 512) {
        const int e = e2 * 2; int ch;
        if (e < 131072) ch = (e >> 14) * 128 + (((e & 16383) >> 11) << 4) + (e & 15); else { const int e3 = e - 131072; ch = 1024 + (e3 >> 15) * 128 + (((e3 & 32767) >> 12) << 4) + (e3 & 15); }
        float S0 = 0.f, S1 = 0.f;
        constexpr int U = 16;
#pragma unroll 1
        for (int cb = 0; cb < NSUPER; cb += U) {
            unsigned d[U]; f32x2v dd[U];
#pragma unroll
            for (int u = 0; u < U; ++u) { d[u] = *(const unsigned*)(SSUP + (size_t)(cb + u) * E_TOTAL + e); dd[u] = *(const f32x2v*)(DSUP + (size_t)(cb + u) * 1536 + ch); }
#pragma unroll
            for (int u = 0; u < U; ++u) {
                *(unsigned*)(SSUP + (size_t)(cb + u) * E_TOTAL + e) = pk(S0, S1);
                S0 = dd[u][0] * S0 + pg8::bf_lo(d[u]); S1 = dd[u][1] * S1 + pg8::bf_hi(d[u]); }
        }
    }
}
}

template <int DV>
__device__ __forceinline__ void naive_scan_batch(const LAS float* q, const LAS float* f, const LAS float* k, const LAS float* v, float (&S)[128], float* obuf_col, int t0, int col) {
#pragma unroll 1
    for (int tt = 0; tt < 16; ++tt) {
        const float vv = v[tt * DV + col]; float o = 0.f;
#pragma unroll
        for (int c = 0; c < 128; c += 4) {
            const f32x4 ff = *(const LAS f32x4*)(f + tt * 128 + c), kk = *(const LAS f32x4*)(k + tt * 128 + c), qq = *(const LAS f32x4*)(q + tt * 128 + c);
#pragma unroll
            for (int j = 0; j < 4; ++j) { S[c + j] = ff[j] * S[c + j] + kk[j] * vv; o += qq[j] * S[c + j]; }
        }
        obuf_col[(size_t)(t0 + tt) * 2048] = o;
    }
}
__device__ __forceinline__ void naive_recurrence(const Args& a, Frame& F, int l, const bf16* Z, const float* GA, float* OBUF) {
    const int b = blockIdx.x; if (b >= 12) return;
    LAS float* q = (LAS float*)(F.lds); LAS float* f = q + 16 * 128; LAS float* k = f + 16 * 128; LAS float* v = k + 16 * 128;
    LAS float* lbv = v + 16 * 256;
    float S[128];
#pragma unroll
    for (int c = 0; c < 128; ++c) S[c] = 0.f;
    if (b < 8) {
        const int hh = b;
        if (F.tid < 128) { const int ch = hh * 128 + F.tid; float lg[DEPTH], mx = -1e30f;
#pragma unroll
            for (int j = 0; j < DEPTH; ++j) { lg[j] = a.lb_logits[j * HGW + ch]; mx = fmaxf(mx, lg[j]); }
            float den = 0.f, num = 0.f;
#pragma unroll
            for (int j = 0; j < DEPTH; ++j) { const float e = __expf(lg[j] - mx); den += e; if (j >= 1 && j <= l) num += e; }
            lbv[F.tid] = num / den; }
        __syncthreads();
        for (int t0 = 0; t0 < M; t0 += 16) {
#pragma unroll
            for (int i = 0; i < 4; ++i) { const int idx = F.tid + 512 * i, tt = idx >> 7, c = idx & 127; const bf16* zr = Z + (size_t)(t0 + tt) * ZW + hh * 128 + c;
                const float zq = bf2f(zr[ZC_HQ]), zf = bf2f(zr[ZC_HF]), zi = bf2f(zr[ZC_HI]); const float lb = lbv[c];
                const float ff = lb + (1.f - lb) * sigmoidf_(zf);
                q[idx] = zq; f[idx] = ff; k[idx] = 1.f - ff; v[idx] = zi; }
            __syncthreads();
            if (F.tid < 128) naive_scan_batch<128>(q, f, k, v, S, OBUF + hh * 128 + F.tid, t0, F.tid);
            __syncthreads();
        }
    } else {
        const int g = b - 8; const float* cw = a.conv_w + (size_t)l * 4 * CONVC; const float* wg = a.w_gate + (size_t)l * GRANK * GKW; const float* bg = a.b_gate + (size_t)l * GKW;
        for (int t0 = 0; t0 < M; t0 += 16) {
#pragma unroll 1
            for (int i = 0; i < 16; ++i) { const int idx = F.tid + 512 * i, tt = idx >> 9, cc = idx & 511;
                int ch; if (cc < 128) ch = g * 128 + cc; else if (cc < 256) ch = 512 + g * 128 + (cc - 128); else ch = 1024 + g * 256 + (cc - 256);
                const int t = t0 + tt; float s = 0.f;
#pragma unroll
                for (int j = 0; j < 4; ++j) { const int ts = t - 3 + j; if (ts >= 0) s += cw[j * CONVC + ch] * bf2f(Z[(size_t)ts * ZW + ZC_GQ + ch]); }
                s = siluf_(s);
                if (cc < 128) q[tt * 128 + cc] = s * 0.08838834764831845f; else if (cc < 256) k[tt * 128 + cc - 128] = s; else v[tt * 256 + cc - 256] = s; }
#pragma unroll
            for (int i = 0; i < 4; ++i) { const int idx = F.tid + 512 * i, tt = idx >> 7, c = idx & 127; float xg = bg[g * 128 + c];
#pragma unroll
                for (int r = 0; r < GRANK; ++r) xg += GA[(size_t)(t0 + tt) * GRANK + r] * wg[r * GKW + g * 128 + c];
                const float ls = fminf(xg, 0.f) - log1pf(__expf(-fabsf(xg)));
                f[idx] = __expf(ls * (1.0f / 16.0f)); }
            __syncthreads();
            if (F.tid < 256) naive_scan_batch<256>(q, f, k, v, S, OBUF + 1024 + g * 256 + F.tid, t0, F.tid);
            __syncthreads();
        }
    }
}
__device__ __forceinline__ void norm_gate_phase(const Args& a, Frame& F, int l, const bf16* Z, const float* OBUF, bf16* Y) {
    const float* ghg = a.g_hg + (size_t)l * HGW; const float* ggl = a.g_gla + (size_t)l * GLAW;
    for (int t = F.gw; t < M; t += F.NGW) {
        const float* orow = OBUF + (size_t)t * 2048; const bf16* zr = Z + (size_t)t * ZW; bf16* yr = Y + (size_t)t * 2048;
#pragma unroll 1
        for (int hh = 0; hh < HGH; ++hh) { const int c = hh * 128 + 2 * F.lane; const float o0 = orow[c], o1 = orow[c + 1];
            const float ms = wave_sum(o0 * o0 + o1 * o1) * (1.0f / 128.0f); const float r = __builtin_amdgcn_rsqf(ms + EPS);
            const float g0 = bf2f(zr[ZC_HG + c]), g1 = bf2f(zr[ZC_HG + c + 1]);
            *(unsigned*)(yr + c) = pk2(o0 * r * ghg[c] * siluf_(g0), o1 * r * ghg[c + 1] * siluf_(g1)); }
#pragma unroll 1
        for (int g = 0; g < GH; ++g) { const int c = g * 256 + 4 * F.lane; float o[4], ss = 0.f;
#pragma unroll
            for (int j = 0; j < 4; ++j) { o[j] = orow[1024 + c + j]; ss += o[j] * o[j]; }
            const float ms = wave_sum(ss) * (1.0f / 256.0f); const float r = __builtin_amdgcn_rsqf(ms + EPS); float y[4];
#pragma unroll
            for (int j = 0; j < 4; ++j) y[j] = o[j] * r * ggl[c + j] * siluf_(bf2f(zr[ZC_GR + c + j]));
            v2u w; w.x = pk2(y[0], y[1]); w.y = pk2(y[2], y[3]); *(v2u*)(yr + 1024 + c) = w; }
    }
}
__device__ __forceinline__ void final_norm(const Args& a, Frame& F, const float* stats, const bf16* hb) {
    const GAS f32x4* gr = (const GAS f32x4*)a.g_final;
    f32x4 g0[4], g1[4];
#pragma unroll
    for (int j = 0; j < 4; ++j) { const int c4 = (64 * j + F.lane) * 2; g0[j] = gr[c4]; g1[j] = gr[c4 + 1]; }
    for (int m = F.gw; m < M; m += F.NGW) {
        GAS f32x4* orow = (GAS f32x4*)(a.out + (size_t)m * D);
        v4u h[4];
#pragma unroll
        for (int j = 0; j < 4; ++j) h[j] = *(const GAS v4u*)(hb + pg8::tile_rc(m, 8 * (F.lane + 64 * j), D));
        float sv = (F.lane < 32) ? stats[(size_t)m * 32 + F.lane] : 0.f; sv = wave_sum(sv);
        const float rstd = __builtin_amdgcn_rsqf(sv * (1.0f / D) + EPS);
#pragma unroll
        for (int j = 0; j < 4; ++j) { const int c4 = (64 * j + F.lane) * 2;
            const f32x4 o0 = {pg8::bf_lo(h[j].x), pg8::bf_hi(h[j].x), pg8::bf_lo(h[j].y), pg8::bf_hi(h[j].y)}, o1 = {pg8::bf_lo(h[j].z), pg8::bf_hi(h[j].z), pg8::bf_lo(h[j].w), pg8::bf_hi(h[j].w)};
            orow[c4] = o0 * rstd * g0[j]; orow[c4 + 1] = o1 * rstd * g1[j]; }
    }
}
__device__ __forceinline__ int fresh_bx() { int b = blockIdx.x; asm volatile("" : "+s"(b)); return b; }
constexpr int PH_PER_LAYER = 8;
constexpr int N_PHASES = 1 + DEPTH * PH_PER_LAYER + 1;

__global__ void __launch_bounds__(NWAVES * 64, 2) hyb_fwd(Args args) {
    extern __shared__ __attribute__((aligned(16))) unsigned char lds[];
    const int wave_s = __builtin_amdgcn_readfirstlane((int)threadIdx.x >> 6);
#define MKFRAME() Frame F; { F.lds = (LAS unsigned char*)lds; F.lane = pg8::fresh_lane(); F.wave = wave_s; F.tid = wave_s * 64 + F.lane; \
        F.G = gridDim.x; F.gw = blockIdx.x * NWAVES + F.wave; F.NGW = F.G * NWAVES; }
    LAS unsigned char* const ldsb = (LAS unsigned char*)lds;
    LAS float* const RTAB = (LAS float*)(ldsb + RTAB_OFF);
    volatile LAS unsigned* MISC = (volatile LAS unsigned*)(ldsb + MISC_OFF);
    for (int u = threadIdx.x; u < LDSCTL_BYTES / 4; u += NWAVES * 64) ((LAS unsigned*)(ldsb + LDSCTL_OFF))[u] = 0u;
    __syncthreads();
#define BARW ((unsigned*)(args.ws + WS_CTL) + CW_BAR)
    XcdBarrier bar; bar.bar = nullptr; bar.x = 0; bar.st = nullptr;
    const int lo = args.ph_lo, hi = args.ph_hi;

    if (hi - lo > 1) { bar = xcd_barrier_post(BARW, MISC + 8); bar.bar = nullptr; }
#define IN(k) (lo <= (k) && (k) < hi)
#define SEAM(k) do { if (IN(k) && IN((k) + 1)) { xcd_barrier(bar, BARW); for (int pb_ = 0; pb_ < PROBE_BAR; ++pb_) xcd_barrier(bar, BARW); } } while (0)

    if (IN(0)) { MKFRAME(); for (int pr_ = 0; pr_ <= PROBE_PRO; ++pr_) prologue(args, F); SEAM(0); }

#define PH_PTRS() GAS unsigned char* wsg_ = (GAS unsigned char*)args.ws; asm volatile("" : "+s"(wsg_)); unsigned char* ws = (unsigned char*)wsg_;     \
    float* const st_mix = (float*)(ws + WS_STATS); float* const st_mlp = (float*)(ws + WS_STATS + STATS_BYTES); float* const st_ple = (float*)(ws + WS_STATS + 2 * STATS_BYTES); \
    bf16* const Z = (bf16*)(ws + WS_UNION + UO_Z); bf16* const ABUF = (bf16*)(ws + WS_UNION + UO_A); bf16* const PP = (bf16*)(ws + WS_UNION + UO_PP); unsigned char* const H8 = ws + WS_UNION + UO_H8; \
    float* const GA = (float*)(ws + WS_GA); bf16* const PB = (bf16*)(ws + WS_PB); \
    bf16* const SB = (bf16*)(ws + WS_UNION + UO_S); bf16* const SSUP = (bf16*)(ws + WS_UNION + UO_SSUP); float* const DSUP = (float*)(ws + WS_DEC); \
    bf16* const hb = (bf16*)(ws + ((l & 1) ? WS_HBB : WS_HBA)); bf16* const yb = (bf16*)(ws + ((l & 1) ? WS_HBA : WS_HBB)); \
    unsigned char* const wl = ws + WS_W + (size_t)l * W_LAYER; \
    (void)H8; (void)st_mix; (void)st_mlp; (void)st_ple; (void)Z; (void)ABUF; (void)PP; (void)GA; (void)PB; (void)SB; (void)SSUP; (void)DSUP; (void)hb; (void)yb; (void)wl;

#pragma unroll 1
    for (int l = 0; l < DEPTH; ++l) {
        const int pbase = 1 + l * PH_PER_LAYER;

        if (IN(pbase + 0)) { PH_PTRS();
            pg8::Gemm g{hb, (const bf16*)(wl + WO_IN), M, ZW, D}; pg8::StaticOrder S; S.init(M, ZW, (int)gridDim.x, fresh_bx());
            pg8::EpiScaleBf16<0, true> E{Z, ZW, st_mix, RTAB};
            for (int pr_ = 0; pr_ < PROBE_GEMM; ++pr_) { pg8::EpiNull EN; pg8::gemm_phase<pg8::EpiNull, pg8::StaticOrder, PG8_ALIGN, PG8_SP2>(ldsb + RING_OFF, wave_s, g, S, EN); }
            for (int pq_ = 0; pq_ <= PROBE_GEMMR; ++pq_) pg8::gemm_phase<pg8::EpiScaleBf16<0, true>, pg8::StaticOrder, PG8_ALIGN, PG8_SP2, false, true>(ldsb + RING_OFF, wave_s, g, S, E);
            { MKFRAME(); ga_phase(args, F, hb, (const bf16*)(wl + WO_GA), st_mix, GA); }
            SEAM(pbase + 0);
        }
        if (IN(pbase + 1)) { PH_PTRS(); { MKFRAME(); pb_phase(args, F, l); } for (int pr_ = 0; pr_ <= PROBE_MIX; ++pr_) mx::mix_phase<false>(args, ldsb, wave_s, l, Z, GA, SB, SSUP, DSUP, yb); SEAM(pbase + 1); }
        if (IN(pbase + 2)) { PH_PTRS(); mx::scan_phase(wave_s, SSUP, DSUP); SEAM(pbase + 2); }
        if (IN(pbase + 3)) { PH_PTRS(); for (int pr_ = 0; pr_ <= PROBE_MIX; ++pr_) mx::mix_phase<true>(args, ldsb, wave_s, l, Z, GA, SB, SSUP, DSUP, yb); SEAM(pbase + 3); }
        if (IN(pbase + 4)) { PH_PTRS();
            pg8::Gemm g{yb, (const bf16*)(wl + WO_OUT), M, D, D}; pg8::StaticOrder S; S.init(M, D, (int)gridDim.x, fresh_bx());
            pg8::EpiResidual<0> E{hb, hb, st_mlp, nullptr, nullptr, D, RTAB, nullptr};
            for (int pr_ = 0; pr_ < PROBE_GEMM; ++pr_) { pg8::EpiNull EN; pg8::gemm_phase<pg8::EpiNull, pg8::StaticOrder, PG8_ALIGN, PG8_SP2>(ldsb + RING_OFF, wave_s, g, S, EN); }
            pg8::gemm_phase<pg8::EpiResidual<0>, pg8::StaticOrder, PG8_ALIGN, PG8_SP2, false, true>(ldsb + RING_OFF, wave_s, g, S, E);
            SEAM(pbase + 4);
        }
        if (IN(pbase + 5)) { PH_PTRS();
            { pg8::Gemm g{hb, (const bf16*)(wl + WO_UP), M, FF, D}; pg8::StaticOrder S; S.init(M, FF, (int)gridDim.x, fresh_bx());
              pg8::EpiScaleBf16<1, true, true> E{ABUF, FF, st_mlp, RTAB};
              for (int pr_ = 0; pr_ < PROBE_GEMM; ++pr_) { pg8::EpiNull EN; pg8::gemm_phase<pg8::EpiNull, pg8::StaticOrder, PG8_ALIGN, PG8_SP2>(ldsb + RING_OFF, wave_s, g, S, EN); }
            for (int pq_ = 0; pq_ <= PROBE_GEMMR; ++pq_) pg8::gemm_phase<pg8::EpiScaleBf16<1, true, true>, pg8::StaticOrder, PG8_ALIGN, PG8_SP2, false, true>(ldsb + RING_OFF, wave_s, g, S, E); }
            SEAM(pbase + 5);
        }
        if (IN(pbase + 6)) { PH_PTRS();
            pg8::Gemm g{ABUF, (const bf16*)(wl + WO_DN), M, D, FF}; pg8::StaticOrder S; S.init(M, D, (int)gridDim.x, fresh_bx(), 4);
            pg8::EpiResidual<2> E{hb, hb, st_ple, nullptr, nullptr, D, RTAB, H8};
            for (int pr_ = 0; pr_ < PROBE_GEMM; ++pr_) { pg8::EpiNull EN; pg8::gemm_phase<pg8::EpiNull, pg8::StaticOrder, PG8_ALIGN, PG8_SP2>(ldsb + RING_OFF, wave_s, g, S, EN); }
            pg8::gemm_phase<pg8::EpiResidual<2>, pg8::StaticOrder, PG8_ALIGN, PG8_SP2, false, true, true, true>(ldsb + RING_OFF, wave_s, g, S, E);
            SEAM(pbase + 6);
        }
        if (IN(pbase + 7)) { PH_PTRS();
            { pg8::Gemm g{PB, (const bf16*)(wl + WO_PP), M, D, PLE}; pg8::StaticOrder S; S.init(M, D, (int)gridDim.x, fresh_bx());
              pg8::EpiScaleBf16<2, true> E{PP, D, nullptr, RTAB};
              for (int pr_ = 0; pr_ < PROBE_GEMM; ++pr_) { pg8::EpiNull EN; pg8::gemm_phase<pg8::EpiNull, pg8::StaticOrder, PG8_ALIGN, PG8_SP2>(ldsb + RING_OFF, wave_s, g, S, EN); }
            for (int pq_ = 0; pq_ <= PROBE_GEMMR; ++pq_) pg8::gemm_phase<pg8::EpiScaleBf16<2, true>, pg8::StaticOrder, PG8_ALIGN, PG8_SP2>(ldsb + RING_OFF, wave_s, g, S, E); }
            pg8::Gemm g{(const bf16*)H8, (const bf16*)(wl + WO_PG), M, D, D / 2}; pg8::StaticOrder S; S.init(M, D, (int)gridDim.x, fresh_bx());
            pg8::EpiResidual<1> E{hb, yb, st_mix, st_ple, PP, D, RTAB, nullptr};
            for (int pr_ = 0; pr_ < PROBE_GEMM; ++pr_) { pg8::EpiNull EN; pg8::gemm_phase<pg8::EpiNull, pg8::StaticOrder, PG8_ALIGN, PG8_SP2, true>(ldsb + RING_OFF, wave_s, g, S, EN); }
            int np5_ = PROBE_G5 + 1; asm volatile("" : "+s"(np5_));
#pragma unroll 1
            for (int pq_ = 0; pq_ < np5_; ++pq_) pg8::gemm_phase<pg8::EpiResidual<1>, pg8::StaticOrder, PG8_ALIGN, PG8_SP2, true, true>(ldsb + RING_OFF, wave_s, g, S, E);
            SEAM(pbase + 7);
        }
    }
    if (IN(N_PHASES - 1)) { const int l = DEPTH; PH_PTRS(); MKFRAME(); final_norm(args, F, st_mix, hb); }

#undef IN
#undef SEAM
}

extern "C" void kernel_launch(void* const* d_in, const int* in_sizes, int n_in, void* d_out, int out_size, void* d_ws, size_t ws_size, hipStream_t stream) {
    static int grid = 0;
    if (grid == 0) {
        if (n_in != 18 || out_size != M * D || ws_size < WS_END) { fprintf(stderr, "kernel_launch: unexpected shapes (n_in %d out %d ws %zu, need %zu); nothing launched\n", n_in, out_size, ws_size, (size_t)WS_END); grid = -1; return; }
        int dev = 0, cus = 0, per_cu = 0;
        if (hipGetDevice(&dev) != hipSuccess || hipDeviceGetAttribute(&cus, hipDeviceAttributeMultiprocessorCount, dev) != hipSuccess) { grid = -1; return; }
        if (hipFuncSetAttribute((const void*)hyb_fwd, hipFuncAttributeMaxDynamicSharedMemorySize, LDS_BYTES) != hipSuccess) { fprintf(stderr, "kernel_launch: hipFuncSetAttribute failed\n"); grid = -1; return; }
        if (hipOccupancyMaxActiveBlocksPerMultiprocessor(&per_cu, (const void*)hyb_fwd, NWAVES * 64, LDS_BYTES) != hipSuccess || per_cu < 1) { fprintf(stderr, "kernel_launch: occupancy query says %d\n", per_cu); }
        (void)hipGetLastError();
        grid = cus;
    }
    if (grid < 0) return;
    if (hipMemsetAsync((char*)d_ws + WS_CTL, 0, CTL_ZERO_BYTES, stream) != hipSuccess) return;
    Args a{};
    const float** pa = (const float**)&a;
    for (int i = 0; i < 18; ++i) pa[i] = (const float*)d_in[i];
    a.out = (float*)d_out; a.ws = (unsigned char*)d_ws;
#if MK_MULTI
    for (int ph = 0; ph < N_PHASES; ++ph) { a.ph_lo = ph; a.ph_hi = ph + 1; hipLaunchKernelGGL(hyb_fwd, dim3(grid), dim3(NWAVES * 64), LDS_BYTES, stream, a); }
#else
    a.ph_lo = 0; a.ph_hi = N_PHASES;
    hipLaunchKernelGGL(hyb_fwd, dim3(grid), dim3(NWAVES * 64), LDS_BYTES, stream, a);
#endif
}
```

```cpp
#include <hip/hip_runtime.h>
#include <cstdio>
#include <cstdint>

#ifndef PROBE_GEMM
#define PROBE_GEMM 0
#endif
#ifndef PROBE_MIX
#define PROBE_MIX 0
#endif
#ifndef PROBE_BAR
#define PROBE_BAR 0
#endif
#ifndef PROBE_SCAN
#define PROBE_SCAN 0
#endif
#ifndef PROBE_GEMMR
#define PROBE_GEMMR 0
#endif
#ifndef PROBE_PRO
#define PROBE_PRO 0
#endif
#ifndef PROBE_G5
#define PROBE_G5 0
#endif
#ifndef MK_MULTI
#define MK_MULTI 0
#endif

namespace pg8 {
#define PG8_LAS __attribute__((address_space(3)))
typedef unsigned short bf16_t;
typedef short bf16x8 __attribute__((ext_vector_type(8)));
typedef float f32x4 __attribute__((ext_vector_type(4)));
typedef unsigned u32x4 __attribute__((ext_vector_type(4)));
typedef unsigned u32x2 __attribute__((ext_vector_type(2)));
constexpr int BM = 256, BK = 64, HALF = 128, HTB = HALF * BK * 2  , STAGE_BYTES = 8 * HTB, NXCD = 8, WGM = 8;

__host__ __device__ __forceinline__ int lds_byte(int r, int c) { const int st = (r >> 4) * 2 + (c >> 5), rr = r & 15, cc = c & 31, ob = rr * 64 + cc * 2; return st * 1024 + (ob ^ (((ob >> 9) & 1) << 5)); }
__host__ __device__ __forceinline__ void stage_rc(int b, int& R, int& C) { const int st = b / 1024, sb = b % 1024, swz = sb ^ (((sb >> 9) & 1) << 5); R = (st >> 1) * 16 + swz / 64; C = (st & 1) * 32 + (swz % 64) / 2; }
__host__ __device__ __forceinline__ int perm32(int rho) { const int n = rho >> 4, i = rho & 15; return 8 * (i >> 2) + 4 * n + (i & 3); }

struct Unit { int pm, pn; };
struct Gemm { const bf16_t* A; const bf16_t* Bt; int M, N, K; };

struct StaticOrder {
    int nM, nN, nwg, G, c, wgm;
    __host__ __device__ void init(int M, int N, int G_, int c_, int wgm_ = WGM) { nM = M / BM; nN = N / BM; nwg = nM * nN; G = G_; c = c_; wgm = wgm_; }
    __host__ __device__ bool next(int i, Unit& u) const {
        const long L = (long)i * G + c; if (L >= nwg) return false;
        int wgid = (int)L; { const int q = nwg / NXCD, r = nwg % NXCD, xcd = wgid % NXCD, off = wgid / NXCD; wgid = (xcd < r ? xcd * (q + 1) : r * (q + 1) + (xcd - r) * q) + off; }
        const int nig = wgm * nN, gid = wgid / nig, fm = gid * wgm, gsz = (nM - fm) < wgm ? (nM - fm) : wgm;
        u.pm = fm + ((wgid % nig) % gsz); u.pn = (wgid % nig) / gsz; return true;
    }
    __device__ __forceinline__ void a_ready(const Unit&) const {}
    __device__ __forceinline__ void done(const Unit&) const {}
};

typedef __bf16 bf16x2_t __attribute__((ext_vector_type(2)));
typedef float f32x2_t __attribute__((ext_vector_type(2)));
__device__ __forceinline__ unsigned cvt_pk_bf16(float lo, float hi) { const f32x2_t f = {lo, hi}; const bf16x2_t b = __builtin_convertvector(f, bf16x2_t); return __builtin_bit_cast(unsigned, b); }
__device__ __forceinline__ float bf_lo(unsigned w) { return __uint_as_float(w << 16); }
__device__ __forceinline__ float bf_hi(unsigned w) { return __uint_as_float(w & 0xffff0000u); }
__device__ __forceinline__ unsigned cvt_pk_fp8x4(float a, float b, float c, float d) { int w = 0; w = __builtin_amdgcn_cvt_pk_fp8_f32(a, b, w, false); w = __builtin_amdgcn_cvt_pk_fp8_f32(c, d, w, true); return (unsigned)w; }
typedef int i32x4_t __attribute__((ext_vector_type(4)));
typedef int i32x8_t __attribute__((ext_vector_type(8)));
__device__ __forceinline__ i32x8_t cat8(bf16x8 lo, bf16x8 hi) { const i32x4_t a = __builtin_bit_cast(i32x4_t, lo), b = __builtin_bit_cast(i32x4_t, hi); return __builtin_shufflevector(a, b, 0, 1, 2, 3, 4, 5, 6, 7); }
__device__ __forceinline__ float sum_xor16(float v) { const unsigned b = __builtin_bit_cast(unsigned, v); const auto r = __builtin_amdgcn_permlane16_swap(b, b, false, false); return __builtin_bit_cast(float, (unsigned)r[0]) + __builtin_bit_cast(float, (unsigned)r[1]); }
__device__ __forceinline__ float sum_xor32(float v) { const unsigned b = __builtin_bit_cast(unsigned, v); const auto r = __builtin_amdgcn_permlane32_swap(b, b, false, false); return __builtin_bit_cast(float, (unsigned)r[0]) + __builtin_bit_cast(float, (unsigned)r[1]); }
template <int CTRL> __device__ __forceinline__ float dpp_get(float v) { return __builtin_bit_cast(float, __builtin_amdgcn_mov_dpp(__builtin_bit_cast(int, v), CTRL, 0xF, 0xF, true)); }
__device__ __forceinline__ float get_xor1(float v) { return __builtin_bit_cast(float, __builtin_amdgcn_mov_dpp(__builtin_bit_cast(int, v), 0xB1, 0xF, 0xF, true)); }
constexpr float F8_WSCALE = 64.0f;

constexpr float RMS_EPS = 1e-6f;
constexpr int DMODEL = 2048;
constexpr int NSTAT = 32;

__device__ __forceinline__ void rstd_table(const float* stats, int pm, int wid, int lane, PG8_LAS float* tab) {
    const int t = wid * 64 + lane, row = t >> 1, half = t & 1;
    const f32x4* p = (const f32x4*)(stats + (size_t)(pm * BM + row) * NSTAT + half * 16);
    const f32x4 a = p[0], b = p[1], c = p[2], d = p[3];
    float s = (((a[0] + a[1]) + (a[2] + a[3])) + ((b[0] + b[1]) + (b[2] + b[3]))) + (((c[0] + c[1]) + (c[2] + c[3])) + ((d[0] + d[1]) + (d[2] + d[3])));
    s += get_xor1(s);
    if (half == 0) tab[row] = __builtin_amdgcn_rsqf(s * (1.0f / DMODEL) + RMS_EPS);
}

__host__ __device__ __forceinline__ size_t tile_rc(int row, int col, int ld) { return (((size_t)(row >> 4) * (ld >> 5) + (col >> 5)) << 9) + (row & 15) * 32 + (col & 31); }
__device__ __forceinline__ size_t tiled_off(int row, int ldc, int pn, int wc, int bj, int fq) { return (((size_t)(row >> 4) * (ldc >> 5) + pn * 8 + wc + bj * 4) << 9) + (row & 15) * 32 + 8 * fq; }
template <int ACT, bool TILED = false> struct EpiScaleBf16 {
    static constexpr bool PERM = true, AFTER_DRAIN = false;
    bf16_t* O; int ldc; const float* stats; PG8_LAS float* tab;
    __device__ __forceinline__ void prepare(const Unit& u, int wid, int lane, int par) const { if (ACT != 2) rstd_table(stats, u.pm, wid, lane, tab + par * 256); }
    __device__ __forceinline__ void operator()(const f32x4 (&acc)[2][2][4][2], const Unit& u, int wr, int wc, int fr, int fq, int wid, int lane, int par) const {
        const int rl0 = wr * 64 + fr, col0 = u.pn * BM + wc * 32 + 8 * fq;
#pragma unroll
        for (int ai = 0; ai < 2; ++ai)
#pragma unroll
            for (int m = 0; m < 4; ++m) { const int rl = rl0 + ai * HALF + m * 16; bf16_t* rowp = O + (size_t)(u.pm * BM + rl) * ldc + col0;
                float sc = 1.0f; if (ACT != 2) sc = tab[par * 256 + rl];
#pragma unroll
                for (int bj = 0; bj < 2; ++bj) { f32x4 v0 = acc[ai][bj][m][0] * sc, v1 = acc[ai][bj][m][1] * sc;
                    if (ACT == 1) {
#pragma unroll
                        for (int j = 0; j < 4; ++j) { const float a0 = fmaxf(v0[j], 0.f), a1 = fmaxf(v1[j], 0.f); v0[j] = a0 * a0; v1[j] = a1 * a1; } }
                    u32x4 w; w.x = cvt_pk_bf16(v0[0], v0[1]); w.y = cvt_pk_bf16(v0[2], v0[3]); w.z = cvt_pk_bf16(v1[0], v1[1]); w.w = cvt_pk_bf16(v1[2], v1[3]);
                    if constexpr (TILED) {
                        const int row = u.pm * BM + rl;
                        *(u32x4*)(O + (((size_t)(row >> 4) * (ldc >> 5) + u.pn * 8 + wc + bj * 4) << 9) + (row & 15) * 32 + 8 * fq) = w;
                    } else *(u32x4*)(rowp + bj * HALF) = w; } }
    }
};

template <int MODE> struct EpiResidual {
    static constexpr bool PERM = true, AFTER_DRAIN = false;
    const bf16_t* hin; bf16_t* hout; float* stats_out; const float* stats_in; const bf16_t* pp; int ldc; PG8_LAS float* tab; unsigned char* h8;
    __device__ __forceinline__ void prepare(const Unit& u, int wid, int lane, int par) const { if (MODE == 1) rstd_table(stats_in, u.pm, wid, lane, tab + par * 256); }
    __device__ __forceinline__ void operator()(const f32x4 (&acc)[2][2][4][2], const Unit& u, int wr, int wc, int fr, int fq, int wid, int lane, int par) const {
        const int rl0 = wr * 64 + fr, col0 = u.pn * BM + wc * 32 + 8 * fq;
#pragma unroll
        for (int ai = 0; ai < 2; ++ai) {
            u32x4 hv[4][2], pw[4][2];
#pragma unroll
            for (int m = 0; m < 4; ++m) { const size_t off = (size_t)(u.pm * BM + rl0 + ai * HALF + m * 16) * ldc + col0;
#pragma unroll
                for (int bj = 0; bj < 2; ++bj) { hv[m][bj] = *(const u32x4*)(hin + tiled_off(u.pm * BM + rl0 + ai * HALF + m * 16, ldc, u.pn, wc, bj, fq)); if (MODE == 1) pw[m][bj] = *(const u32x4*)(pp + tiled_off(u.pm * BM + rl0 + ai * HALF + m * 16, ldc, u.pn, wc, bj, fq)); } }
#pragma unroll
            for (int m = 0; m < 4; ++m) { const int rl = rl0 + ai * HALF + m * 16, row = u.pm * BM + rl; const size_t off = (size_t)row * ldc + col0; float ss = 0.f;
                float sc2 = 0.f; if (MODE == 1) sc2 = tab[par * 256 + rl] * (-1.4426950408889634f / F8_WSCALE);
#pragma unroll
                for (int bj = 0; bj < 2; ++bj) {
                    f32x4 v0 = acc[ai][bj][m][0], v1 = acc[ai][bj][m][1];
                    if (MODE == 1) {
                        const u32x4 q = pw[m][bj];
                        const float pv[8] = {bf_lo(q.x), bf_hi(q.x), bf_lo(q.y), bf_hi(q.y), bf_lo(q.z), bf_hi(q.z), bf_lo(q.w), bf_hi(q.w)};
#pragma unroll
                        for (int j = 0; j < 4; ++j) {
                            const float g0 = __builtin_amdgcn_rcpf(1.0f + __builtin_amdgcn_exp2f(v0[j] * sc2)), g1 = __builtin_amdgcn_rcpf(1.0f + __builtin_amdgcn_exp2f(v1[j] * sc2));
                            v0[j] = g0 * pv[j]; v1[j] = g1 * pv[4 + j]; }
                    }
                    const u32x4 h = hv[m][bj];
                    v0 = v0 + (f32x4){bf_lo(h.x), bf_hi(h.x), bf_lo(h.y), bf_hi(h.y)}; v1 = v1 + (f32x4){bf_lo(h.z), bf_hi(h.z), bf_lo(h.w), bf_hi(h.w)};
                    u32x4 w; w.x = cvt_pk_bf16(v0[0], v0[1]); w.y = cvt_pk_bf16(v0[2], v0[3]); w.z = cvt_pk_bf16(v1[0], v1[1]); w.w = cvt_pk_bf16(v1[2], v1[3]);
                    *(u32x4*)(hout + tiled_off(row, ldc, u.pn, wc, bj, fq)) = w;
                    if (MODE == 2) { u32x2 w8; w8.x = cvt_pk_fp8x4(v0[0], v0[1], v0[2], v0[3]); w8.y = cvt_pk_fp8x4(v1[0], v1[1], v1[2], v1[3]); const int bc = u.pn * BM + bj * HALF + wc * 32 + 8 * fq;
                        *(u32x2*)(h8 + ((((size_t)(row >> 4) * (ldc >> 6)) + (bc >> 6)) << 10) + (row & 15) * 64 + (bc & 63)) = w8; }
                    ss += (v0[0] * v0[0] + v0[1] * v0[1]) + (v0[2] * v0[2] + v0[3] * v0[3]) + (v1[0] * v1[0] + v1[1] * v1[1]) + (v1[2] * v1[2] + v1[3] * v1[3]);
                }
                ss = sum_xor16(ss); ss = sum_xor32(ss);
                if (fq == 0) stats_out[(size_t)row * NSTAT + u.pn * 4 + wc] = ss;
            }
            asm volatile("" ::: "memory");
        }
    }
};

struct EpiNull { static constexpr bool PERM = true, AFTER_DRAIN = false;
    __device__ __forceinline__ void prepare(const Unit&, int, int, int) const {}
    __device__ __forceinline__ void operator()(const f32x4 (&acc)[2][2][4][2], const Unit&, int, int, int, int, int, int, int) const {
#pragma unroll
        for (int a = 0; a < 2; ++a)
#pragma unroll
            for (int b = 0; b < 2; ++b)
#pragma unroll
                for (int m = 0; m < 4; ++m)
#pragma unroll
                    for (int n = 0; n < 2; ++n) asm volatile("" :: "v"(acc[a][b][m][n])); } };
__device__ __forceinline__ int fresh_lane() { int l; asm volatile("v_mbcnt_lo_u32_b32 %0, -1, 0\n\tv_mbcnt_hi_u32_b32 %0, -1, %0" : "=v"(l)); return l; }
template <class Epi, class Sched, bool ALIGN_EPI = false, bool SP2 = false, bool FP8 = false, bool ATILED = false, bool BTILED = true>
__device__ __forceinline__ void gemm_phase(PG8_LAS unsigned char* lds, const int wid_in, const Gemm g, const Sched& S, const Epi& E) {
    int wid = wid_in; asm volatile("" : "+s"(wid));
    const int lane = fresh_lane(), tid = wid * 64 + lane, wr = wid >> 2, wc = wid & 3, fr = lane & 15, fq = lane >> 4;
    const int K = g.K, nt = K / BK;
    unsigned voffA[2], voffB[2];
#pragma unroll
    for (int i = 0; i < 2; ++i) { int R, C; stage_rc(tid * 16 + i * 8192, R, C); const int Rb = Epi::PERM ? ((R & ~31) + perm32(R & 31)) : R;
        voffA[i] = ATILED ? (unsigned)((((R >> 4) * (K >> 5) + (C >> 5)) << 10) + (R & 15) * 64 + (C & 31) * 2) : (unsigned)(R * K + C) * 2u; voffB[i] = BTILED ? (unsigned)((((R >> 4) * (K >> 5) + (C >> 5)) << 10) + (R & 15) * 64 + (C & 31) * 2) : (unsigned)(Rb * K + C) * 2u; }
    const size_t kstep = (size_t)(BK * 2);
    const size_t kstepA = ATILED ? (size_t)2048 : kstep;
    const size_t kstepB = BTILED ? (size_t)2048 : kstep;
    const size_t hstep = (size_t)HALF * K * 2;
    const size_t tstep = 2 * hstep;
    const unsigned ldsw = (unsigned)wid * 1024u;
    const int aoff = lds_byte(wr * 64 + fr, fq * 8), boff = lds_byte(wc * 32 + fr, fq * 8);
#define PG8_SA(b, h) (((b) * 2 + (h)) * HTB)
#define PG8_SB(b, h) ((4 + (b) * 2 + (h)) * HTB)
#define PG8_STAGE(bufoff, gbase, voff) do { _Pragma("unroll") for (int _i = 0; _i < 2; ++_i) { unsigned _vo = (voff)[_i]; if constexpr (FP8) asm volatile("" : "+v"(_vo));    \
        __builtin_amdgcn_global_load_lds((const unsigned*)((const char*)(gbase) + _vo), (PG8_LAS unsigned*)(lds + (bufoff) + ldsw + _i * 8192), 16, 0, 0); } } while (0)
#define PG8_LDA(dst, b, h) do { _Pragma("unroll") for (int m = 0; m < 4; ++m) _Pragma("unroll") for (int k = 0; k < 2; ++k) dst[m][k] = *(const PG8_LAS bf16x8*)(lds + PG8_SA(b, h) + aoff + m * 2048 + k * 1024); } while (0)
#define PG8_LDB(dst, b, h) do { _Pragma("unroll") for (int n = 0; n < 2; ++n) _Pragma("unroll") for (int k = 0; k < 2; ++k) dst[n][k] = *(const PG8_LAS bf16x8*)(lds + PG8_SB(b, h) + boff + n * 2048 + k * 1024); } while (0)
#define PG8_MMA(ai, bj, At, Bt) do { __builtin_amdgcn_s_setprio(1); _Pragma("unroll") for (int m = 0; m < 4; ++m) _Pragma("unroll") for (int n = 0; n < 2; ++n) { \
        if constexpr (FP8) acc[ai][bj][m][n] = __builtin_amdgcn_mfma_scale_f32_16x16x128_f8f6f4(cat8(Bt[n][0], Bt[n][1]), cat8(At[m][0], At[m][1]), acc[ai][bj][m][n], 0, 0, 0, 0, 0, 0);   \
        else { _Pragma("unroll") for (int k = 0; k < 2; ++k) acc[ai][bj][m][n] = __builtin_amdgcn_mfma_f32_16x16x32_bf16(Bt[n][k], At[m][k], acc[ai][bj][m][n], 0, 0, 0); } } \
        __builtin_amdgcn_s_setprio(0); } while (0)
#define PG8_WAIT_V(n) asm volatile("s_waitcnt vmcnt(" #n ")" ::: "memory")
#define PG8_WAIT_L(n) asm volatile("s_waitcnt lgkmcnt(" #n ")" ::: "memory")
#define PG8_BAR __builtin_amdgcn_s_barrier()
#define PG8_SCHED __builtin_amdgcn_sched_barrier(0)
    Unit cur, nxt; int ui = 0;
    if (!S.next(0, cur)) return;
    f32x4 acc[2][2][4][2];
#pragma unroll
    for (int a = 0; a < 2; ++a)
#pragma unroll
        for (int b = 0; b < 2; ++b)
#pragma unroll
            for (int m = 0; m < 4; ++m)
#pragma unroll
                for (int n = 0; n < 2; ++n) acc[a][b][m][n] = (f32x4){0.f, 0.f, 0.f, 0.f};
    bf16x8 At[4][2], B0[2][2], B1[2][2];
    const char* cA = (const char*)g.A + (size_t)cur.pm * tstep; const char* cB = (const char*)g.Bt + (size_t)cur.pn * tstep;
    S.a_ready(cur);
    if constexpr (SP2) {
        PG8_STAGE(PG8_SB(0, 0), cB, voffB); PG8_STAGE(PG8_SB(0, 1), cB + hstep, voffB); PG8_STAGE(PG8_SA(0, 0), cA, voffA); PG8_STAGE(PG8_SA(0, 1), cA + hstep, voffA);
        E.prepare(cur, wid, lane, 0);
        if (wr == 1) PG8_BAR;
        PG8_WAIT_V(2); PG8_BAR;
        PG8_STAGE(PG8_SB(1, 0), cB + kstepB, voffB); PG8_STAGE(PG8_SA(1, 0), cA + kstepA, voffA); PG8_STAGE(PG8_SB(1, 1), cB + hstep + kstepB, voffB);
        PG8_WAIT_V(6); PG8_BAR;
    } else {
        PG8_STAGE(PG8_SB(0, 0), cB, voffB); PG8_STAGE(PG8_SA(0, 0), cA, voffA); PG8_STAGE(PG8_SB(0, 1), cB + hstep, voffB); PG8_STAGE(PG8_SA(0, 1), cA + hstep, voffA);
        E.prepare(cur, wid, lane, 0);
        if (wr == 1) PG8_BAR;
        PG8_WAIT_V(4); PG8_BAR;
        PG8_STAGE(PG8_SB(1, 0), cB + kstepB, voffB); PG8_STAGE(PG8_SA(1, 0), cA + kstepA, voffA); PG8_STAGE(PG8_SB(1, 1), cB + hstep + kstepB, voffB);
        PG8_WAIT_V(6); PG8_BAR;
    }
    for (;;) {
        const bool has_next = S.next(ui + 1, nxt);
        const char* nA = has_next ? (const char*)g.A + (size_t)nxt.pm * tstep : cA; const char* nB = has_next ? (const char*)g.Bt + (size_t)nxt.pn * tstep : cB;
#pragma unroll 1
        for (int t = 0; t < nt; t += 2) {
            const bool last = (t == nt - 2);
            const char* a1 = cA + (size_t)(t + 1) * kstepA;
            const char* a2 = last ? nA : cA + (size_t)(t + 2) * kstepA; const char* b2 = last ? nB : cB + (size_t)(t + 2) * kstepB;
            const char* a3 = a2 + kstepA; const char* b3 = b2 + kstepB;
            if (last && has_next) S.a_ready(nxt);
            if constexpr (SP2) {
            PG8_LDB(B0, 0, 0); PG8_LDB(B1, 0, 1); PG8_SCHED; PG8_LDA(At, 0, 0); PG8_STAGE(PG8_SA(1, 1), a1 + hstep, voffA);
            PG8_WAIT_V(8); PG8_WAIT_L(0); PG8_BAR; PG8_MMA(0, 0, At, B0); PG8_MMA(0, 1, At, B1); PG8_BAR; PG8_SCHED;
            PG8_LDA(At, 0, 1); PG8_STAGE(PG8_SB(0, 0), b2, voffB); PG8_STAGE(PG8_SB(0, 1), b2 + hstep, voffB); PG8_STAGE(PG8_SA(0, 0), a2, voffA);
            PG8_WAIT_V(8); PG8_WAIT_L(0); PG8_BAR; PG8_MMA(1, 0, At, B0); PG8_MMA(1, 1, At, B1); PG8_BAR; PG8_SCHED;
            PG8_LDB(B0, 1, 0); PG8_LDB(B1, 1, 1); PG8_SCHED; PG8_LDA(At, 1, 0); PG8_STAGE(PG8_SA(0, 1), a2 + hstep, voffA);
            PG8_WAIT_V(8); PG8_WAIT_L(0); PG8_BAR; PG8_MMA(0, 0, At, B0); PG8_MMA(0, 1, At, B1); PG8_BAR; PG8_SCHED;
            PG8_LDA(At, 1, 1); PG8_STAGE(PG8_SB(1, 0), b3, voffB); PG8_STAGE(PG8_SB(1, 1), b3 + hstep, voffB); PG8_STAGE(PG8_SA(1, 0), a3, voffA);
            PG8_WAIT_V(8); PG8_WAIT_L(0); PG8_BAR; PG8_MMA(1, 0, At, B0); PG8_MMA(1, 1, At, B1); PG8_BAR; PG8_SCHED;
            } else {
            PG8_LDB(B0, 0, 0); PG8_SCHED; PG8_LDA(At, 0, 0); PG8_STAGE(PG8_SA(1, 1), a1 + hstep, voffA);
            PG8_WAIT_L(8); PG8_BAR; PG8_WAIT_L(0); PG8_MMA(0, 0, At, B0); PG8_BAR; PG8_SCHED;
            PG8_LDB(B1, 0, 1); PG8_STAGE(PG8_SB(0, 0), b2, voffB);
            PG8_BAR; PG8_WAIT_L(0); PG8_MMA(0, 1, At, B1); PG8_BAR;
            PG8_LDA(At, 0, 1); PG8_STAGE(PG8_SA(0, 0), a2, voffA);
            PG8_BAR; PG8_WAIT_L(0); PG8_MMA(1, 0, At, B0); PG8_BAR; PG8_SCHED;
            PG8_STAGE(PG8_SB(0, 1), b2 + hstep, voffB);
            PG8_WAIT_V(6); PG8_BAR; PG8_MMA(1, 1, At, B1); PG8_BAR;
            PG8_LDB(B0, 1, 0); PG8_SCHED; PG8_LDA(At, 1, 0); PG8_STAGE(PG8_SA(0, 1), a2 + hstep, voffA);
            PG8_WAIT_L(8); PG8_BAR; PG8_WAIT_L(0); PG8_MMA(0, 0, At, B0); PG8_BAR; PG8_SCHED;
            PG8_LDB(B1, 1, 1); PG8_STAGE(PG8_SB(1, 0), b3, voffB);
            PG8_BAR; PG8_WAIT_L(0); PG8_MMA(0, 1, At, B1); PG8_BAR;
            PG8_LDA(At, 1, 1); PG8_STAGE(PG8_SA(1, 0), a3, voffA);
            PG8_BAR; PG8_WAIT_L(0); PG8_MMA(1, 0, At, B0); PG8_BAR; PG8_SCHED;
            PG8_STAGE(PG8_SB(1, 1), b3 + hstep, voffB);
            PG8_WAIT_V(6); PG8_BAR; PG8_MMA(1, 1, At, B1); PG8_BAR;
            }
        }
        if constexpr (ALIGN_EPI) { if (wr == 0) PG8_BAR; }
        { const int l2 = fresh_lane(); E(acc, cur, wr, wc, l2 & 15, l2 >> 4, wid, l2, ui & 1); } S.done(cur);
        if (!has_next) break;
#pragma unroll
        for (int a = 0; a < 2; ++a)
#pragma unroll
            for (int b = 0; b < 2; ++b)
#pragma unroll
                for (int m = 0; m < 4; ++m)
#pragma unroll
                    for (int n = 0; n < 2; ++n) acc[a][b][m][n] = (f32x4){0.f, 0.f, 0.f, 0.f};
        cur = nxt; cA = nA; cB = nB; ++ui;
        if constexpr (ALIGN_EPI) { if (wr == 1) PG8_BAR; }
        { const int l3 = fresh_lane(); E.prepare(cur, wid, l3, ui & 1); }
    }
    PG8_WAIT_V(0);
    if constexpr (!ALIGN_EPI) { if (wr == 0) PG8_BAR; }
    PG8_BAR;
#undef PG8_SA
#undef PG8_SB
#undef PG8_STAGE
#undef PG8_LDA
#undef PG8_LDB
#undef PG8_MMA
#undef PG8_WAIT_V
#undef PG8_WAIT_L
#undef PG8_BAR
#undef PG8_SCHED
}
}

#ifndef PG8_SP2
#define PG8_SP2 true
#endif
#ifndef PG8_ALIGN
#define PG8_ALIGN true
#endif

constexpr int NWAVES = 8;
constexpr int M = 16384, D = 2048, DEPTH = 4, FF = 8192, INW = 7184, ZW = 7168, PLE = 256;
constexpr int HGW = 1024, HGH = 8, HD = 128;
constexpr int GH = 4, GDK = 128, GDV = 256, GKW = 512, GLAW = 1024, GRANK = 16;
constexpr int ZC_HQ = 0, ZC_HF = 1024, ZC_HI = 2048, ZC_HG = 3072, ZC_GQ = 4096, ZC_GK = 4608, ZC_GV = 5120, ZC_GR = 6144;
constexpr int CONVC = 2048;
constexpr float EPS = 1e-6f;
constexpr int CHUNK = 64, NCHUNK = M / CHUNK;

constexpr size_t MiB = 1u << 20;
constexpr size_t WS_CTL = 0, CTL_ZERO_BYTES = 1 * MiB;
constexpr size_t WS_STATS = 1 * MiB;
constexpr size_t STATS_BYTES = (size_t)M * 32 * 4;
constexpr size_t WS_GA = 7 * MiB;
constexpr size_t WS_DEC = 8 * MiB;
constexpr size_t WS_PB = 12 * MiB;
constexpr size_t WS_HBA = 20 * MiB, WS_HBB = 84 * MiB;
constexpr size_t WS_W = 148 * MiB, W_LAYER = 110 * MiB;
constexpr size_t WO_IN = 0, WO_OUT = 28 * MiB, WO_UP = 36 * MiB, WO_DN = 68 * MiB, WO_PG = 100 * MiB, WO_PP = 108 * MiB, WO_GA = 109 * MiB;
constexpr size_t WS_UNION = 588 * MiB;
constexpr size_t UO_Z = 0, UO_OBUF = 224 * MiB, UO_S = 224 * MiB, UO_SSUP = 352 * MiB, UO_A = 0, UO_PP = 256 * MiB, UO_H8 = 320 * MiB  ;
constexpr size_t WS_END = 972 * MiB;

constexpr int CW_BAR = 4096;

constexpr int RING_OFF = 0, RING_BYTES = 131072;
constexpr int LDS_BYTES = 163840;
constexpr int RTAB_OFF = RING_BYTES;
constexpr int LDSCTL_BYTES = 1024, LDSCTL_OFF = LDS_BYTES - LDSCTL_BYTES, MISC_OFF = LDSCTL_OFF + 320;

#define GAS __attribute__((address_space(1)))
#define LAS __attribute__((address_space(3)))
typedef unsigned short bf16;
typedef unsigned v4u __attribute__((ext_vector_type(4)));
typedef unsigned v2u __attribute__((ext_vector_type(2)));
typedef float f32x4 __attribute__((ext_vector_type(4)));
typedef GAS unsigned gu32;
#define LDS_WAIT() asm volatile("s_waitcnt lgkmcnt(0)" ::: "memory")
#define VM_WAIT() asm volatile("s_waitcnt vmcnt(0)" ::: "memory")
__device__ __forceinline__ unsigned f2bf(float f) { unsigned u = __builtin_bit_cast(unsigned, f); return (u + 0x7fffu + ((u >> 16) & 1u)) >> 16; }
__device__ __forceinline__ unsigned pk2(float lo, float hi) { return f2bf(lo) | (f2bf(hi) << 16); }
__device__ __forceinline__ float bf2f(bf16 b) { return __uint_as_float(((unsigned)b) << 16); }

#define XB_TMO      128
#define XB_XCNT(j)  (256  + 64 * (j))
#define XB_XSUB(j)  (1280 + 64 * (j))
#define XB_XGEN(j)  (2304 + 64 * (j))
#define XB_TOP      3328
#define XB_TOPGEN   3392
#define XCD_BAR_WORDS 3456
#define XB_SPIN_CAP (1u << 20)
__device__ __forceinline__ unsigned xb_ld(unsigned* p)              { return __hip_atomic_load(p, __ATOMIC_RELAXED, __HIP_MEMORY_SCOPE_AGENT); }
__device__ __forceinline__ unsigned xb_add(unsigned* p, unsigned v) { return __hip_atomic_fetch_add(p, v, __ATOMIC_RELAXED, __HIP_MEMORY_SCOPE_AGENT); }
__device__ __forceinline__ unsigned xb_xcc_id() { return (unsigned)__builtin_amdgcn_s_getreg((3 << 11) | 20) & 0xFu; }
#define XB_SPIN(cond, bar) do { unsigned _sp = 0; while (cond) { __builtin_amdgcn_s_sleep(1); \
    if ((++_sp & 255u) == 0u) { if (xb_ld(&(bar)[XB_TMO])) break; if (_sp > XB_SPIN_CAP) { atomicAdd(&(bar)[XB_TMO], 1u); break; } } } } while (0)
struct XcdBarrier { unsigned* bar; unsigned x; volatile LAS unsigned* st; };
__device__ __forceinline__ XcdBarrier xcd_barrier_post(unsigned* bar, volatile LAS unsigned* st) {
    XcdBarrier b; b.bar = bar; b.x = xb_xcc_id(); b.st = st;
    if (threadIdx.x == 0) (void)xb_add(&bar[XB_XCNT(b.x)], 1u);
    return b;
}
__device__ __forceinline__ void xcd_barrier_complete(unsigned* bar, unsigned x, unsigned& nloc, unsigned& nx) {
    const unsigned G = gridDim.x * gridDim.y * gridDim.z;
    unsigned sum, cnt, mine, sp = 0u;
    for (;;) {
        sum = 0u; cnt = 0u; mine = 0u;
#pragma unroll 1
        for (unsigned j = 0; j < 16; ++j) { const unsigned c = xb_ld(&bar[XB_XCNT(j)]); sum += c; cnt += (c > 0u) ? 1u : 0u; mine = (j == x) ? c : mine; }
        if (sum == G) break;
        __builtin_amdgcn_s_sleep(1);
        if ((++sp & 255u) == 0u) { if (xb_ld(&bar[XB_TMO])) break; if (sp > XB_SPIN_CAP) { atomicAdd(&bar[XB_TMO], 1u); break; } }
    }
    nloc = mine > 0u ? mine : 1u; nx = cnt > 0u ? cnt : 1u;
}
__device__ __forceinline__ void xcd_barrier(const XcdBarrier& b, unsigned* barw_in) {
    asm volatile("s_waitcnt vmcnt(0)" ::: "memory");
    __syncthreads();
    if (threadIdx.x == 0) {
        unsigned* bar = barw_in; asm volatile("" : "+s"(bar));
        __builtin_amdgcn_s_waitcnt(0);
        unsigned nloc = b.st[0], nx = b.st[1];
        if (nloc == 0u) { xcd_barrier_complete(bar, b.x, nloc, nx); b.st[0] = nloc; b.st[1] = nx; }
        const unsigned old = xb_add(&bar[XB_XSUB(b.x)], 1u);
        const unsigned gen = old / nloc;
        if (old + 1u == (gen + 1u) * nloc) {
            __builtin_amdgcn_fence(__ATOMIC_RELEASE, "agent");
            asm volatile("s_waitcnt vmcnt(0)" ::: "memory");
            const unsigned og = xb_add(&bar[XB_TOP], 1u);
            const unsigned tg = og / nx;
            if (og + 1u == (tg + 1u) * nx) xb_add(&bar[XB_TOPGEN], 1u);
            else XB_SPIN(xb_ld(&bar[XB_TOPGEN]) == tg, bar);
            __builtin_amdgcn_fence(__ATOMIC_ACQUIRE, "agent");
            xb_add(&bar[XB_XGEN(b.x)], 1u);
            asm volatile("s_waitcnt vmcnt(0)" ::: "memory");
        } else {
            XB_SPIN(xb_ld(&bar[XB_XGEN(b.x)]) == gen, bar);
            __builtin_amdgcn_fence(__ATOMIC_ACQUIRE, "agent");
            asm volatile("s_waitcnt vmcnt(0)" ::: "memory");
        }
    }
    __syncthreads();
}

struct Args {
    const float *x, *p, *g_mix, *w_in, *lb_logits, *g_hg, *conv_w, *w_gate, *b_gate, *g_gla, *w_out, *g_mlp, *w_up, *w_down, *g_ple, *w_pg, *w_pp, *g_final;
    float* out; unsigned char* ws; int ph_lo, ph_hi;
};
struct Frame {
    LAS unsigned char* lds;
    int tid, lane, wave, G, gw, NGW;
};
__device__ __forceinline__ float wave_sum(float v) {
    v += pg8::dpp_get<0xB1>(v); v += pg8::dpp_get<0x4E>(v); v += pg8::dpp_get<0x141>(v); v += pg8::dpp_get<0x140>(v);
    return pg8::sum_xor32(pg8::sum_xor16(v));
}
__device__ __forceinline__ float sigmoidf_(float x) { return __builtin_amdgcn_rcpf(1.0f + __builtin_amdgcn_exp2f(x * -1.4426950408889634f)); }
__device__ __forceinline__ float siluf_(float x) { return x * __builtin_amdgcn_rcpf(1.0f + __builtin_amdgcn_exp2f(x * -1.4426950408889634f)); }

template <bool F8 = false, bool TILED = true>
__device__ __forceinline__ void transpose_item(const float* W, int ldw, int k0, int n0, int ncols, bf16* WT, int K, int nrow0, const float* g, LAS float* scr, int lane) {
    const int r4 = lane >> 4, c4 = lane & 15;
    f32x4 v[16];
#pragma unroll
    for (int i = 0; i < 16; ++i) { const int row = 4 * i + r4; v[i] = (f32x4){0.f, 0.f, 0.f, 0.f}; if (c4 * 4 < ncols) v[i] = *(const f32x4*)(W + (size_t)(k0 + row) * ldw + n0 + c4 * 4); }
#pragma unroll
    for (int i = 0; i < 16; ++i) { const int row = 4 * i + r4; const float gs = (g ? g[k0 + row] : 1.0f) * (F8 ? pg8::F8_WSCALE : 1.0f);
        *(LAS f32x4*)(scr + row * 68 + ((c4 * 4) ^ ((row >> 3) << 2))) = v[i] * gs; }
    LDS_WAIT(); asm volatile("" ::: "memory");
    if constexpr (TILED) {
        const int r = lane >> 2, kp = lane & 3;
#pragma unroll
        for (int j = 0; j < 8; ++j) { const int blk = j >> 2, gq = (j >> 1) & 1, ksub = j & 1, k8 = ksub * 4 + kp, n = blk * 32 + pg8::perm32(16 * gq + r), q = nrow0 + blk * 32 + 16 * gq + r;
            const LAS float* s = scr + (8 * k8) * 68 + (n ^ (k8 << 2));
            if constexpr (F8) {
                v2u o8; o8.x = pg8::cvt_pk_fp8x4(s[0 * 68], s[1 * 68], s[2 * 68], s[3 * 68]); o8.y = pg8::cvt_pk_fp8x4(s[4 * 68], s[5 * 68], s[6 * 68], s[7 * 68]);
                *(GAS v2u*)((unsigned char*)WT + (((size_t)(q >> 4) * (K >> 6) + (k0 >> 6)) << 10) + (q & 15) * 64 + 8 * k8) = o8;
            } else {
                v4u o; o.x = pg8::cvt_pk_bf16(s[0 * 68], s[1 * 68]); o.y = pg8::cvt_pk_bf16(s[2 * 68], s[3 * 68]); o.z = pg8::cvt_pk_bf16(s[4 * 68], s[5 * 68]); o.w = pg8::cvt_pk_bf16(s[6 * 68], s[7 * 68]);
                *(GAS v4u*)(WT + (((size_t)(q >> 4) * (K >> 5) + (k0 >> 5) + ksub) << 9) + (q & 15) * 32 + 8 * kp) = o; } }
    } else {
    const int c = lane & 7;
    #pragma unroll
        for (int j = 0; j < 8; ++j) { const int n = (lane >> 3) + 8 * j; const LAS float* s = scr + (8 * c) * 68 + (n ^ (c << 2));
            if constexpr (F8) {
                v2u o8; o8.x = pg8::cvt_pk_fp8x4(s[0 * 68], s[1 * 68], s[2 * 68], s[3 * 68]); o8.y = pg8::cvt_pk_fp8x4(s[4 * 68], s[5 * 68], s[6 * 68], s[7 * 68]);
                if (n < ncols) *(GAS v2u*)((unsigned char*)WT + (size_t)(nrow0 + n) * K + k0 + 8 * c) = o8; continue; }
            v4u o; o.x = pg8::cvt_pk_bf16(s[0 * 68], s[1 * 68]); o.y = pg8::cvt_pk_bf16(s[2 * 68], s[3 * 68]); o.z = pg8::cvt_pk_bf16(s[4 * 68], s[5 * 68]); o.w = pg8::cvt_pk_bf16(s[6 * 68], s[7 * 68]);
            if (n < ncols) *(GAS v4u*)(WT + (size_t)(nrow0 + n) * K + k0 + 8 * c) = o; }
}
    LDS_WAIT(); asm volatile("" ::: "memory");
}

__device__ __forceinline__ void prologue(const Args& a, Frame& F) {
    LAS float* scr = (LAS float*)(F.lds + RING_OFF + F.wave * 17408);
    constexpr int I_IN = 32 * 112, I_GA = 32, I_OUT = 32 * 32, I_UP = 32 * 128, I_DN = 128 * 32, I_PG = 32 * 32, I_PP = 4 * 32;
    constexpr int I_LAYER = I_IN + I_GA + I_OUT + I_UP + I_DN + I_PG + I_PP;
    for (int it = F.gw; it < DEPTH * I_LAYER; it += F.NGW) {
        const int l = it / I_LAYER; int r = it % I_LAYER;
        unsigned char* wl = a.ws + WS_W + (size_t)l * W_LAYER;
        if (r < I_IN) { const int kb = r / 112, nb = r % 112; transpose_item(a.w_in + (size_t)l * D * INW, INW, 64 * kb, 64 * nb, 64, (bf16*)(wl + WO_IN), D, 64 * nb, a.g_mix + l * D, scr, F.lane); continue; } r -= I_IN;
        if (r < I_GA) { transpose_item<false, false>(a.w_in + (size_t)l * D * INW, INW, 64 * r, ZW, 16, (bf16*)(wl + WO_GA), D, 0, a.g_mix + l * D, scr, F.lane); continue; } r -= I_GA;
        if (r < I_OUT) { const int kb = r / 32, nb = r % 32; transpose_item(a.w_out + (size_t)l * D * D, D, 64 * kb, 64 * nb, 64, (bf16*)(wl + WO_OUT), D, 64 * nb, nullptr, scr, F.lane); continue; } r -= I_OUT;
        if (r < I_UP) { const int kb = r / 128, nb = r % 128; transpose_item(a.w_up + (size_t)l * D * FF, FF, 64 * kb, 64 * nb, 64, (bf16*)(wl + WO_UP), D, 64 * nb, a.g_mlp + l * D, scr, F.lane); continue; } r -= I_UP;
        if (r < I_DN) { const int kb = r / 32, nb = r % 32; transpose_item(a.w_down + (size_t)l * FF * D, D, 64 * kb, 64 * nb, 64, (bf16*)(wl + WO_DN), FF, 64 * nb, nullptr, scr, F.lane); continue; } r -= I_DN;
        if (r < I_PG) { const int kb = r / 32, nb = r % 32; transpose_item<true>(a.w_pg + (size_t)l * D * D, D, 64 * kb, 64 * nb, 64, (bf16*)(wl + WO_PG), D, 64 * nb, a.g_ple + l * D, scr, F.lane); continue; } r -= I_PG;
        { const int kb = r / 32, nb = r % 32; transpose_item(a.w_pp + (size_t)l * PLE * D, D, 64 * kb, 64 * nb, 64, (bf16*)(wl + WO_PP), PLE, 64 * nb, nullptr, scr, F.lane); }
    }
    bf16* hb = (bf16*)(a.ws + WS_HBA); float* st = (float*)(a.ws + WS_STATS);
    for (int m0 = F.gw; m0 < M; m0 += 2 * F.NGW) {
        f32x4 v[2][8];
#pragma unroll
        for (int r = 0; r < 2; ++r) { const int m = m0 + r * F.NGW; if (m < M) { const GAS f32x4* xr = (const GAS f32x4*)(a.x + (size_t)m * D) + F.lane;
#pragma unroll
            for (int j = 0; j < 8; ++j) v[r][j] = xr[64 * j]; } }
#pragma unroll
        for (int r = 0; r < 2; ++r) { const int m = m0 + r * F.NGW; if (m < M) { float s = 0.f;
#pragma unroll
            for (int j = 0; j < 8; ++j) { const f32x4 q = v[r][j]; s += (q.x * q.x + q.y * q.y) + (q.z * q.z + q.w * q.w); v2u w; w.x = pg8::cvt_pk_bf16(q.x, q.y); w.y = pg8::cvt_pk_bf16(q.z, q.w); *(GAS v2u*)(hb + pg8::tile_rc(m, 4 * (F.lane + 64 * j), D)) = w; }
            s = wave_sum(s);
            if (F.lane < 32) st[(size_t)m * 32 + F.lane] = (F.lane == 0) ? s : 0.f; } }
    }
}

__device__ __forceinline__ void ga_phase(const Args& a, Frame& F, const bf16* hb, const bf16* wga, const float* stats, float* GA) {
    typedef short bf16x8g __attribute__((ext_vector_type(8)));
    const int fr = F.lane & 15, fq = F.lane >> 4, tl = F.wave & 3, kh = F.wave >> 2;
    LAS f32x4* part = (LAS f32x4*)(F.lds);
    for (int t = blockIdx.x * 4 + tl; t < M / 16; t += F.G * 4) {
        const int row0 = t * 16;
        const bf16* ap = hb + pg8::tile_rc(row0 + fr, kh * (D / 2) + fq * 8, D);
        const bf16* bp = wga + (size_t)fr * D + kh * (D / 2) + fq * 8;
        f32x4 acc = {0.f, 0.f, 0.f, 0.f};
#pragma unroll 8
        for (int kk = 0; kk < D / 64; ++kk) {
            const bf16x8g av = *(const bf16x8g*)(ap + kk * 512), bv = *(const bf16x8g*)(bp + kk * 32);
            acc = __builtin_amdgcn_mfma_f32_16x16x32_bf16(av, bv, acc, 0, 0, 0); }
        if (kh == 1) part[tl * 64 + F.lane] = acc;
        __syncthreads();
        if (kh == 0) {
            acc = acc + part[tl * 64 + F.lane];
            const f32x4* sp = (const f32x4*)(stats + (size_t)(row0 + fr) * 32 + fq * 8); const f32x4 s0 = sp[0], s1 = sp[1];
            float sv = ((s0[0] + s0[1]) + (s0[2] + s0[3])) + ((s1[0] + s1[1]) + (s1[2] + s1[3]));
            sv = pg8::sum_xor16(sv); sv = pg8::sum_xor32(sv);
            const float rstd = __builtin_amdgcn_rsqf(sv * (1.0f / D) + EPS);
#pragma unroll
            for (int i = 0; i < 4; ++i) GA[(size_t)(row0 + 4 * fq + i) * GRANK + fr] = acc[i] * __builtin_bit_cast(float, __builtin_amdgcn_ds_bpermute((4 * fq + i) * 4, __builtin_bit_cast(int, rstd)));
        }
        __syncthreads();
    }
}

__device__ __forceinline__ void pb_phase(const Args& a, Frame& F, int l) {
    const GAS f32x4* src = (const GAS f32x4*)(a.p + (size_t)l * M * PLE); GAS v2u* dst = (GAS v2u*)(a.ws + WS_PB);
    const size_t n4 = (size_t)M * PLE / 4;
    const size_t stride = (size_t)F.G * 512;
    for (size_t i0 = (size_t)blockIdx.x * 512 + F.tid; i0 < n4; i0 += 8 * stride) {
        f32x4 v[8];
#pragma unroll
        for (int j = 0; j < 8; ++j) { const size_t i = i0 + j * stride; v[j] = (i < n4) ? src[i] : (f32x4){0.f, 0.f, 0.f, 0.f}; }
#pragma unroll
        for (int j = 0; j < 8; ++j) { const size_t i = i0 + j * stride; if (i < n4) { v2u w; w.x = pg8::cvt_pk_bf16(v[j].x, v[j].y); w.y = pg8::cvt_pk_bf16(v[j].z, v[j].w); dst[i] = w; } }
    }
}

namespace mx {
typedef short bf16x8 __attribute__((ext_vector_type(8)));
typedef float f32x2v __attribute__((ext_vector_type(2)));
constexpr int AR = 0;
constexpr int RS128 = 272, RS256 = 528, TS = 144;
constexpr int RW128 = 256, RW256 = 512;
constexpr int A_RAWQ = 0, A_RAWK = 17408, A_RAWV = 34816;
constexpr int A_GAT = 69632;
constexpr int A_QT = 73728, A_KT = 91136, A_KDT = A_QT, A_VT = 108544, A_P = 145408;
constexpr int A_TOT = 154624, A_RED = 156672, A_DV = 158720, A_EMV = 159232, A_END = 159744;
constexpr int A_YST = A_QT;
static_assert(AR + A_END <= LDSCTL_OFF, "mixer arena vs LDS control words");
constexpr int E_TOTAL = 8 * 128 * 128 + 4 * 256 * 128;
constexpr int SUPER = 4, NSUPER = NCHUNK / SUPER;
constexpr float XCL = 100.0f;

template <int DV> __device__ __forceinline__ size_t st_off(int v, int k4, int fq) { return ((size_t)((2 * k4 + (fq >> 1)) * DV + v) << 4) + 8 * (fq & 1); }
__device__ __forceinline__ float clampx(float x) { return fminf(fmaxf(x, -XCL), XCL); }
__device__ __forceinline__ void wg_sync() { asm volatile("s_waitcnt vmcnt(0) lgkmcnt(0)" ::: "memory"); __builtin_amdgcn_s_barrier(); asm volatile("" ::: "memory"); }
__device__ __forceinline__ void wg_sync_lds() { asm volatile("s_waitcnt lgkmcnt(0)" ::: "memory"); __builtin_amdgcn_s_barrier(); asm volatile("" ::: "memory"); }
__device__ __forceinline__ unsigned pk(float lo, float hi) { return pg8::cvt_pk_bf16(lo, hi); }

template <bool GLA, bool M3>
__device__ __forceinline__ void raw_issue(LAS unsigned char* ar, const int wave, const int lane, const bf16* Z, const float* GAg, const unsigned char* zero_page, const int t0, const int hu, const int buf) {
    const int oK = (!GLA && !M3 && buf) ? A_RAWQ : A_RAWK, oV = A_RAWV + ((!GLA && !M3 && buf) ? 17408 : 0);
#define MX_DMA(src, dstoff) __builtin_amdgcn_global_load_lds((const unsigned*)(src), (LAS unsigned*)(ar + (dstoff)), 16, 0, 0)
    if (!GLA) {
#pragma unroll
        for (int i = 0; i < 2; ++i) { const int pi = wave + 8 * i, row = 4 * pi + (lane >> 4), pc = lane & 15;
            const bf16* src = Z + pg8::tile_rc(t0 + row, hu * 128 + pc * 8, ZW);
            if (M3) MX_DMA(src + ZC_HQ * 16, A_RAWQ + pi * 1024);
            MX_DMA(src + ZC_HF * 16, oK + pi * 1024);
            MX_DMA(src + ZC_HI * 16, oV + pi * 1024); }
    } else {
#pragma unroll
        for (int i = 0; i < 3; ++i) { const int pi = wave + 8 * i;
            if (pi < 17) { int row = 4 * pi + (lane >> 4); row = row < 67 ? row : 66; const int pc = lane & 15, t = t0 - 3 + row;
                const unsigned char* base = (t < 0) ? (zero_page + pc * 16) : (const unsigned char*)(Z + pg8::tile_rc(t < 0 ? 0 : t, hu * 128 + pc * 8, ZW));
                const unsigned char* sq = (t < 0) ? base : base + ZC_GQ * 32; const unsigned char* sk = (t < 0) ? base : base + ZC_GK * 32;
                if (M3) MX_DMA(sq, A_RAWQ + pi * 1024);
                MX_DMA(sk, A_RAWK + pi * 1024); } }
#pragma unroll
        for (int i = 0; i < 5; ++i) { const int pi = wave + 8 * i;
            if (pi < 34) { int row = 2 * pi + (lane >> 5); row = row < 67 ? row : 66; const int pc = lane & 31, t = t0 - 3 + row;
                const unsigned char* sv = (t < 0) ? (zero_page + pc * 16) : (const unsigned char*)(Z + pg8::tile_rc(t < 0 ? 0 : t, ZC_GV + hu * 256 + pc * 8, ZW));
                MX_DMA(sv, A_RAWV + pi * 1024); } }
        if (wave < 4) MX_DMA(GAg + (size_t)t0 * GRANK + wave * 256 + lane * 4, A_GAT + wave * 1024);
    }
#undef MX_DMA
}

template <bool GLA, bool M3> struct Carry {
    static constexpr int DV = GLA ? 256 : 128, NVT = DV / 128;
    f32x4 acc[M3 ? 1 : DV / 16];
    v4u S[M3 ? NVT : 1][4];
    float dsum, lb;
};

template <bool GLA, bool M3>
__device__ __forceinline__ void mix_step(const Args& a, LAS unsigned char* ar, const int wave, const int lane, const int l, const int chunk, const int hu, const int j4,
                                         const bool has_next, const int nchunk, const int nhu,
                                         const bf16* Z, const float* GAg, const unsigned char* zero_page, bf16* SB, bf16* SSUP, float* DSUP, bf16* Y, Carry<GLA, M3>& C) {
    const int tid = wave * 64 + lane, t0 = chunk * CHUNK;
    constexpr int DV = GLA ? 256 : 128, NVT = DV / 128;
    const int c = tid & 127, seg = tid >> 7;
    const int fr = lane & 15, fq = lane >> 4;
    const int chq = GLA ? (1024 + hu * 128) : (hu * 128);
    const size_t eoff = GLA ? (131072 + hu * 32768) : (hu * 16384);
    const size_t sbase = (size_t)chunk * E_TOTAL + eoff, supbase = (size_t)(chunk / SUPER) * E_TOTAL + eoff;
    float ck0 = 0.f, ck1 = 0.f, ck2 = 0.f, ck3 = 0.f, cq0 = 0.f, cq1 = 0.f, cq2 = 0.f, cq3 = 0.f, bgv = 0.f;
    float wgf[8];
    if (GLA) {
        const float* cwk = a.conv_w + (size_t)l * 4 * CONVC + 512 + hu * 128 + c; ck0 = cwk[0]; ck1 = cwk[CONVC]; ck2 = cwk[2 * CONVC]; ck3 = cwk[3 * CONVC];
        if (M3) { const float* cwq = a.conv_w + (size_t)l * 4 * CONVC + hu * 128 + c; cq0 = cwq[0]; cq1 = cwq[CONVC]; cq2 = cwq[2 * CONVC]; cq3 = cwq[3 * CONVC]; }
        bgv = a.b_gate[(size_t)l * GKW + hu * 128 + c];
        const float* wgp = a.w_gate + (size_t)l * GRANK * GKW + (size_t)((fq & 1) * 8) * GKW + hu * 128 + wave * 16 + fr;
#pragma unroll
        for (int r = 0; r < 8; ++r) wgf[r] = (fq < 2) ? wgp[r * GKW] : 0.f;
    }
    wg_sync();
    constexpr bool DBUF = !GLA && !M3;
    const int oK = (DBUF && (j4 & 1)) ? A_RAWQ : A_RAWK, oV = A_RAWV + ((DBUF && (j4 & 1)) ? 17408 : 0);
    if (DBUF && has_next) raw_issue<GLA, M3>(ar, wave, lane, Z, GAg, zero_page, nchunk * CHUNK, nhu, (j4 + 1) & 1);
    constexpr int XGP = 132;
    if (GLA) {
        const bf16x8 bw = __builtin_bit_cast(bf16x8, (v4u){pk(wgf[0], wgf[1]), pk(wgf[2], wgf[3]), pk(wgf[4], wgf[5]), pk(wgf[6], wgf[7])});
#pragma unroll
        for (int tt = 0; tt < 4; ++tt) {
            const LAS f32x4* gp = (const LAS f32x4*)(ar + A_GAT + (tt * 16 + fr) * 64 + (fq & 1) * 32); const f32x4 g0 = gp[0], g1 = gp[1];
            const v4u aw = {pk(g0[0], g0[1]), pk(g0[2], g0[3]), pk(g1[0], g1[1]), pk(g1[2], g1[3])};
            const bf16x8 ag = __builtin_bit_cast(bf16x8, (fq < 2) ? aw : (v4u){0u, 0u, 0u, 0u});
            f32x4 xa = {0.f, 0.f, 0.f, 0.f};
            xa = __builtin_amdgcn_mfma_f32_16x16x32_bf16(ag, bw, xa, 0, 0, 0);
#pragma unroll
            for (int i = 0; i < 4; ++i) ((LAS float*)(ar + A_QT))[(tt * 16 + 4 * fq + i) * XGP + wave * 16 + fr] = xa[i]; }
        wg_sync_lds();
    }
    constexpr bool HOIST = M3 && !GLA;
    v4u dsl[M3 ? NVT : 1][4]; v2u gate[M3 ? NVT : 1][4];
    const bf16* dsrc = (j4 < SUPER - 1) ? (SB + sbase) : (const bf16*)zero_page;
    const int gcol0 = GLA ? (ZC_GR + hu * 256) : (ZC_HG + hu * 128);
    if (HOIST) {
#pragma unroll
        for (int jv = 0; jv < NVT; ++jv) {
#pragma unroll
            for (int k4 = 0; k4 < 4; ++k4) dsl[jv][k4] = *(const v4u*)(dsrc + st_off<DV>((wave + 8 * jv) * 16 + fr, k4, fq));
#pragma unroll
            for (int tt = 0; tt < 4; ++tt) gate[jv][tt] = *(const v2u*)(Z + pg8::tile_rc(t0 + tt * 16 + fr, gcol0 + (wave + 8 * jv) * 16 + 4 * fq, ZW)); }
    }
    {
        const int sg = tid >> 7;
#pragma unroll
        for (int j = 0; j < NVT; ++j) { const int v = (tid & 127) + 128 * j; unsigned w[8];
            if (!GLA) {
#pragma unroll
                for (int i = 0; i < 8; ++i) { const unsigned lo = *(const LAS bf16*)(ar + oV + (sg * 16 + 2 * i) * RW128 + v * 2), hi = *(const LAS bf16*)(ar + oV + (sg * 16 + 2 * i + 1) * RW128 + v * 2); w[i] = lo | (hi << 16); }
            } else {
                const float* cw = a.conv_w + (size_t)l * 4 * CONVC + 1024 + hu * 256 + v; const float w0 = cw[0], w1 = cw[CONVC], w2 = cw[2 * CONVC], w3 = cw[3 * CONVC];
                float x0 = bf2f(*(const LAS bf16*)(ar + A_RAWV + (sg * 16 + 0) * RW256 + v * 2)), x1 = bf2f(*(const LAS bf16*)(ar + A_RAWV + (sg * 16 + 1) * RW256 + v * 2)), x2 = bf2f(*(const LAS bf16*)(ar + A_RAWV + (sg * 16 + 2) * RW256 + v * 2));
                float o[16];
#pragma unroll
                for (int i = 0; i < 16; ++i) { const float x3 = bf2f(*(const LAS bf16*)(ar + A_RAWV + (sg * 16 + i + 3) * RW256 + v * 2)); o[i] = siluf_(w0 * x0 + w1 * x1 + w2 * x2 + w3 * x3); x0 = x1; x1 = x2; x2 = x3; }
#pragma unroll
                for (int i = 0; i < 8; ++i) w[i] = pk(o[2 * i], o[2 * i + 1]);
            }
            v4u wa = {w[0], w[1], w[2], w[3]}, wb = {w[4], w[5], w[6], w[7]};
            *(LAS v4u*)(ar + A_VT + v * TS + sg * 32) = wa; *(LAS v4u*)(ar + A_VT + v * TS + sg * 32 + 16) = wb; }
    }
    {
        float lf[16], kk[16], qq[16];
        if (!GLA) {
            const float lb = C.lb;
#pragma unroll
            for (int i = 0; i < 16; ++i) { const int lt = seg * 16 + i; const float zf = bf2f(*(const LAS bf16*)(ar + oK + lt * RW128 + c * 2));
                const float en = __builtin_amdgcn_exp2f(zf * -1.4426950408889634f), sg = __builtin_amdgcn_rcpf(1.0f + en), f = lb + (1.0f - lb) * sg;
                lf[i] = __builtin_amdgcn_logf(f); kk[i] = (1.0f - lb) * (en * sg);
                if (M3) qq[i] = bf2f(*(const LAS bf16*)(ar + A_RAWQ + lt * RW128 + c * 2)); }
        } else {
            float xk0 = bf2f(*(const LAS bf16*)(ar + A_RAWK + (seg * 16 + 0) * RW128 + c * 2)), xk1 = bf2f(*(const LAS bf16*)(ar + A_RAWK + (seg * 16 + 1) * RW128 + c * 2)), xk2 = bf2f(*(const LAS bf16*)(ar + A_RAWK + (seg * 16 + 2) * RW128 + c * 2));
            float xq0 = 0.f, xq1 = 0.f, xq2 = 0.f;
            if (M3) { xq0 = bf2f(*(const LAS bf16*)(ar + A_RAWQ + (seg * 16 + 0) * RW128 + c * 2)); xq1 = bf2f(*(const LAS bf16*)(ar + A_RAWQ + (seg * 16 + 1) * RW128 + c * 2)); xq2 = bf2f(*(const LAS bf16*)(ar + A_RAWQ + (seg * 16 + 2) * RW128 + c * 2)); }
#pragma unroll
            for (int i = 0; i < 16; ++i) { const int lt = seg * 16 + i;
                const float xk3 = bf2f(*(const LAS bf16*)(ar + A_RAWK + (lt + 3) * RW128 + c * 2)); kk[i] = siluf_(ck0 * xk0 + ck1 * xk1 + ck2 * xk2 + ck3 * xk3); xk0 = xk1; xk1 = xk2; xk2 = xk3;
                if (M3) { const float xq3 = bf2f(*(const LAS bf16*)(ar + A_RAWQ + (lt + 3) * RW128 + c * 2)); qq[i] = siluf_(cq0 * xq0 + cq1 * xq1 + cq2 * xq2 + cq3 * xq3) * 0.08838834764831845f; xq0 = xq1; xq1 = xq2; xq2 = xq3; }
                const float xg = bgv + ((const LAS float*)(ar + A_QT))[lt * XGP + c];
                lf[i] = (fminf(xg, 0.f) * 1.4426950408889634f - __builtin_amdgcn_logf(1.0f + __builtin_amdgcn_exp2f(fabsf(xg) * -1.4426950408889634f))) * (1.0f / 16.0f); }
        }
#pragma unroll
        for (int i = 1; i < 16; ++i) lf[i] += lf[i - 1];
        ((LAS float*)(ar + A_TOT))[seg * 128 + c] = lf[15];
        wg_sync_lds();
        if (!DBUF && has_next) raw_issue<GLA, M3>(ar, wave, lane, Z, GAg, zero_page, nchunk * CHUNK, nhu, 0);
        const float t0s = ((const LAS float*)(ar + A_TOT))[c], t1s = ((const LAS float*)(ar + A_TOT))[128 + c], t2s = ((const LAS float*)(ar + A_TOT))[256 + c], t3s = ((const LAS float*)(ar + A_TOT))[384 + c];
        const float mref = t0s + t1s, blast = (t0s + t1s) + (t2s + t3s);
        const float off = (seg == 0) ? 0.f : (seg == 1) ? t0s : (seg == 2) ? (t0s + t1s) : ((t0s + t1s) + t2s);
        if (seg == 0) { ((LAS float*)(ar + A_DV))[c] = __builtin_amdgcn_exp2f(blast); if (M3) ((LAS float*)(ar + A_EMV))[c] = __builtin_amdgcn_exp2f(mref); }
        if (M3) {
#pragma unroll
            for (int i = 0; i < 16; ++i) { const int lt = seg * 16 + i; const float b = off + lf[i];
                const unsigned qk = pk(qq[i] * __builtin_amdgcn_exp2f(fminf(b - mref, XCL)), kk[i] * __builtin_amdgcn_exp2f(fminf(mref - b, XCL)));
                *(LAS bf16*)(ar + A_QT + lt * RS128 + c * 2) = (bf16)(qk & 0xffffu);
                *(LAS bf16*)(ar + A_KT + lt * RS128 + c * 2) = (bf16)(qk >> 16); }
        } else {
            unsigned w[8];
#pragma unroll
            for (int i = 0; i < 8; ++i) { const float b0 = off + lf[2 * i], b1 = off + lf[2 * i + 1]; w[i] = pk(kk[2 * i] * __builtin_amdgcn_exp2f(blast - b0), kk[2 * i + 1] * __builtin_amdgcn_exp2f(blast - b1)); }
            v4u wa = {w[0], w[1], w[2], w[3]}, wb = {w[4], w[5], w[6], w[7]};
            *(LAS v4u*)(ar + A_KDT + c * TS + seg * 32) = wa; *(LAS v4u*)(ar + A_KDT + c * TS + seg * 32 + 16) = wb;
            if (seg == 0) { C.dsum += blast; if (j4 == SUPER - 1) DSUP[(size_t)(chunk / SUPER) * 1536 + chq + c] = __builtin_amdgcn_exp2f(C.dsum); }
        }
    }
    wg_sync_lds();
    if (!M3) {
        const bf16x8 a0 = *(const LAS bf16x8*)(ar + A_KDT + (wave * 16 + fr) * TS + fq * 16), a1 = *(const LAS bf16x8*)(ar + A_KDT + (wave * 16 + fr) * TS + fq * 16 + 64);
        const f32x4 dv = *(const LAS f32x4*)(ar + A_DV + (wave * 16 + 4 * fq) * 4);
        const size_t orow = ((size_t)(wave * DV + (fq & 1) * 16 + fr) << 4) + 4 * (fq & ~1);
#pragma unroll
        for (int vt = 0; vt < DV / 16; vt += 2) {
            f32x4 t2[2];
#pragma unroll
            for (int h = 0; h < 2; ++h) {
                const bf16x8 b0 = *(const LAS bf16x8*)(ar + A_VT + ((vt + h) * 16 + fr) * TS + fq * 16), b1 = *(const LAS bf16x8*)(ar + A_VT + ((vt + h) * 16 + fr) * TS + fq * 16 + 64);
                f32x4 t = {0.f, 0.f, 0.f, 0.f};
                t = __builtin_amdgcn_mfma_f32_16x16x32_bf16(a0, b0, t, 0, 0, 0);
                t = __builtin_amdgcn_mfma_f32_16x16x32_bf16(a1, b1, t, 0, 0, 0);
                t2[h] = t; }
            if (j4 < SUPER - 1) {
                const auto r0 = __builtin_amdgcn_permlane16_swap(pk(t2[0][0], t2[0][1]), pk(t2[1][0], t2[1][1]), false, false);
                const auto r1 = __builtin_amdgcn_permlane16_swap(pk(t2[0][2], t2[0][3]), pk(t2[1][2], t2[1][3]), false, false);
                v4u o; o.x = (unsigned)r0[0]; o.y = (unsigned)r1[0]; o.z = (unsigned)r0[1]; o.w = (unsigned)r1[1];
                *(v4u*)(SB + sbase + (size_t)vt * 16 * 16 + orow) = o; }
            C.acc[vt] = C.acc[vt] * dv + t2[0]; C.acc[vt + 1] = C.acc[vt + 1] * dv + t2[1];
            if (j4 == SUPER - 1) {
                const auto r0 = __builtin_amdgcn_permlane16_swap(pk(C.acc[vt][0], C.acc[vt][1]), pk(C.acc[vt + 1][0], C.acc[vt + 1][1]), false, false);
                const auto r1 = __builtin_amdgcn_permlane16_swap(pk(C.acc[vt][2], C.acc[vt][3]), pk(C.acc[vt + 1][2], C.acc[vt + 1][3]), false, false);
                v4u o; o.x = (unsigned)r0[0]; o.y = (unsigned)r1[0]; o.z = (unsigned)r0[1]; o.w = (unsigned)r1[1];
                *(v4u*)(SSUP + supbase + (size_t)vt * 16 * 16 + orow) = o; } }
    } else {
        {
            const int tt = wave & 3;
#pragma unroll
            for (int j = 0; j < 2; ++j) { const int st = (wave >> 2) * 2 + j;
                f32x4 acc = {0.f, 0.f, 0.f, 0.f};
#pragma unroll
                for (int k4 = 0; k4 < 4; ++k4) { const bf16x8 ak = *(const LAS bf16x8*)(ar + A_KT + (st * 16 + fr) * RS128 + fq * 16 + k4 * 64), bq = *(const LAS bf16x8*)(ar + A_QT + (tt * 16 + fr) * RS128 + fq * 16 + k4 * 64);
                    acc = __builtin_amdgcn_mfma_f32_16x16x32_bf16(ak, bq, acc, 0, 0, 0); }
#pragma unroll
                for (int i = 0; i < 4; ++i) acc[i] = (st * 16 + 4 * fq + i <= tt * 16 + fr) ? acc[i] : 0.f;
                v2u o; o.x = pk(acc[0], acc[1]); o.y = pk(acc[2], acc[3]);
                *(LAS v2u*)(ar + A_P + (tt * 16 + fr) * TS + (st * 16 + 4 * fq) * 2) = o; }
        }
        if (!HOIST) {
#pragma unroll
            for (int jv = 0; jv < NVT; ++jv)
#pragma unroll
                for (int tt = 0; tt < 4; ++tt) gate[jv][tt] = *(const v2u*)(Z + pg8::tile_rc(t0 + tt * 16 + fr, gcol0 + (wave + 8 * jv) * 16 + 4 * fq, ZW));
        }
        wg_sync_lds();
        f32x4 oacc[NVT][4];
#pragma unroll
        for (int jv = 0; jv < NVT; ++jv) { const int vt = wave + 8 * jv;
            const bf16x8 va0 = *(const LAS bf16x8*)(ar + A_VT + (vt * 16 + fr) * TS + fq * 16), va1 = *(const LAS bf16x8*)(ar + A_VT + (vt * 16 + fr) * TS + fq * 16 + 64);
            bf16x8 sa[4];
            if (!HOIST) {
#pragma unroll
                for (int k4 = 0; k4 < 4; ++k4) dsl[jv][k4] = *(const v4u*)(dsrc + st_off<DV>(vt * 16 + fr, k4, fq));
            }
#pragma unroll
            for (int k4 = 0; k4 < 4; ++k4) { const f32x4 e0 = *(const LAS f32x4*)(ar + A_EMV + (k4 * 32 + fq * 8) * 4), e1 = *(const LAS f32x4*)(ar + A_EMV + (k4 * 32 + fq * 8 + 4) * 4);
                const v4u sp = C.S[jv][k4]; v4u w;
                w.x = pk(pg8::bf_lo(sp.x) * e0[0], pg8::bf_hi(sp.x) * e0[1]); w.y = pk(pg8::bf_lo(sp.y) * e0[2], pg8::bf_hi(sp.y) * e0[3]);
                w.z = pk(pg8::bf_lo(sp.z) * e1[0], pg8::bf_hi(sp.z) * e1[1]); w.w = pk(pg8::bf_lo(sp.w) * e1[2], pg8::bf_hi(sp.w) * e1[3]);
                sa[k4] = __builtin_bit_cast(bf16x8, w); }
#pragma unroll
            for (int tt = 0; tt < 4; ++tt) { f32x4 acc = {0.f, 0.f, 0.f, 0.f};
                const bf16x8 p0 = *(const LAS bf16x8*)(ar + A_P + (tt * 16 + fr) * TS + fq * 16);
                acc = __builtin_amdgcn_mfma_f32_16x16x32_bf16(va0, p0, acc, 0, 0, 0);
                if (tt >= 2) { const bf16x8 p1 = *(const LAS bf16x8*)(ar + A_P + (tt * 16 + fr) * TS + fq * 16 + 64); acc = __builtin_amdgcn_mfma_f32_16x16x32_bf16(va1, p1, acc, 0, 0, 0); }
#pragma unroll
                for (int k4 = 0; k4 < 4; ++k4) { const bf16x8 bq = *(const LAS bf16x8*)(ar + A_QT + (tt * 16 + fr) * RS128 + fq * 16 + k4 * 64); acc = __builtin_amdgcn_mfma_f32_16x16x32_bf16(sa[k4], bq, acc, 0, 0, 0); }
                oacc[jv][tt] = acc; }
            {
#pragma unroll
                for (int k4 = 0; k4 < 4; ++k4) { const f32x4 d0 = *(const LAS f32x4*)(ar + A_DV + (k4 * 32 + fq * 8) * 4), d1 = *(const LAS f32x4*)(ar + A_DV + (k4 * 32 + fq * 8 + 4) * 4);
                    const v4u sp = C.S[jv][k4], dl = dsl[jv][k4]; v4u w;
                    w.x = pk(pg8::bf_lo(sp.x) * d0[0] + pg8::bf_lo(dl.x), pg8::bf_hi(sp.x) * d0[1] + pg8::bf_hi(dl.x)); w.y = pk(pg8::bf_lo(sp.y) * d0[2] + pg8::bf_lo(dl.y), pg8::bf_hi(sp.y) * d0[3] + pg8::bf_hi(dl.y));
                    w.z = pk(pg8::bf_lo(sp.z) * d1[0] + pg8::bf_lo(dl.z), pg8::bf_hi(sp.z) * d1[1] + pg8::bf_hi(dl.z)); w.w = pk(pg8::bf_lo(sp.w) * d1[2] + pg8::bf_lo(dl.w), pg8::bf_hi(sp.w) * d1[3] + pg8::bf_hi(dl.w));
                    C.S[jv][k4] = w; }
            }
        }
#pragma unroll
        for (int tt = 0; tt < 4; ++tt) { float ss = 0.f;
#pragma unroll
            for (int jv = 0; jv < NVT; ++jv) ss += (oacc[jv][tt][0] * oacc[jv][tt][0] + oacc[jv][tt][1] * oacc[jv][tt][1]) + (oacc[jv][tt][2] * oacc[jv][tt][2] + oacc[jv][tt][3] * oacc[jv][tt][3]);
            ss = pg8::sum_xor16(ss); ss = pg8::sum_xor32(ss);
            if (fq == 0) ((LAS float*)(ar + A_RED))[(tt * 16 + fr) * 8 + wave] = ss; }
        wg_sync_lds();
        const float* gn = GLA ? (a.g_gla + (size_t)l * GLAW + hu * 256) : (a.g_hg + (size_t)l * HGW + hu * 128);
#pragma unroll
        for (int tt = 0; tt < 4; ++tt) { const int t = tt * 16 + fr;
            const f32x4 r0 = *(const LAS f32x4*)(ar + A_RED + t * 32), r1 = *(const LAS f32x4*)(ar + A_RED + t * 32 + 16);
            const float ms = (((r0[0] + r0[1]) + (r0[2] + r0[3])) + ((r1[0] + r1[1]) + (r1[2] + r1[3]))) * (1.0f / DV);
            const float rstd = __builtin_amdgcn_rsqf(ms + EPS);
#pragma unroll
            for (int jv = 0; jv < NVT; ++jv) { const int v = (wave + 8 * jv) * 16 + 4 * fq;
                const f32x4 g4 = *(const f32x4*)(gn + v); const v2u gw = gate[jv][tt];
                const float y0 = oacc[jv][tt][0] * rstd * g4[0] * siluf_(pg8::bf_lo(gw.x)), y1 = oacc[jv][tt][1] * rstd * g4[1] * siluf_(pg8::bf_hi(gw.x));
                const float y2 = oacc[jv][tt][2] * rstd * g4[2] * siluf_(pg8::bf_lo(gw.y)), y3 = oacc[jv][tt][3] * rstd * g4[3] * siluf_(pg8::bf_hi(gw.y));
                v2u o; o.x = pk(y0, y1); o.y = pk(y2, y3);
                *(LAS v2u*)(ar + A_YST + t * (GLA ? RS256 : RS128) + v * 2) = o; } }
        wg_sync_lds();
        {
            constexpr int PPR = DV / 8;
            const int ycol0 = GLA ? (1024 + hu * 256) : (hu * 128);
#pragma unroll
            for (int i = 0; i < (64 * PPR) / 512; ++i) { const int sidx = wave + 8 * i, rg = sidx / (DV / 32), scol = sidx % (DV / 32), r = rg * 16 + (lane >> 2), cc = scol * 32 + (lane & 3) * 8;
                *(v4u*)(Y + pg8::tile_rc(t0 + r, ycol0 + cc, 2048)) = *(const LAS v4u*)(ar + A_YST + r * (GLA ? RS256 : RS128) + cc * 2); }
        }
    }
}

template <bool GLA, bool M3>
__device__ __forceinline__ void mix_head(const Args& a, LAS unsigned char* ar, const int wave, const int l, const int sc, const int hu, const bf16* Z, const float* GAg, const unsigned char* zero_page, bf16* SB, bf16* SSUP, float* DSUP, bf16* Y) {
    constexpr int DV = GLA ? 256 : 128, NVT = DV / 128;
    Carry<GLA, M3> C; C.dsum = 0.f; C.lb = 0.f;
    {
        const int lane = pg8::fresh_lane(), tid = wave * 64 + lane, fr = lane & 15, fq = lane >> 4;
        raw_issue<GLA, M3>(ar, wave, lane, Z, GAg, zero_page, sc * SUPER * CHUNK, hu, 0);
        if (!GLA) { const int ch = hu * 128 + (tid & 127); float lg[DEPTH], mxv = -1e30f;
#pragma unroll
            for (int j = 0; j < DEPTH; ++j) { lg[j] = a.lb_logits[j * HGW + ch]; mxv = fmaxf(mxv, lg[j]); }
            float den = 0.f, num = 0.f;
#pragma unroll
            for (int j = 0; j < DEPTH; ++j) { const float e = __expf(lg[j] - mxv); den += e; if (j >= 1 && j <= l) num += e; }
            C.lb = num / den; }
        if (M3) {
            const size_t supbase = (size_t)sc * E_TOTAL + (GLA ? (131072 + hu * 32768) : (hu * 16384));
#pragma unroll
            for (int jv = 0; jv < NVT; ++jv)
#pragma unroll
                for (int k4 = 0; k4 < 4; ++k4) C.S[jv][k4] = *(const v4u*)(SSUP + supbase + st_off<DV>((wave + 8 * jv) * 16 + fr, k4, fq));
        } else {
#pragma unroll
            for (int vt = 0; vt < DV / 16; ++vt) C.acc[vt] = (f32x4){0.f, 0.f, 0.f, 0.f};
        }
    }
#pragma unroll 1
    for (int j = 0; j < SUPER; ++j) { const int lane = pg8::fresh_lane();
        mix_step<GLA, M3>(a, ar, wave, lane, l, sc * SUPER + j, hu, j, j + 1 < SUPER, sc * SUPER + j + 1, hu, Z, GAg, zero_page, SB, SSUP, DSUP, Y, C); }
    wg_sync();
}
template <bool M3>
__device__ __forceinline__ void mix_phase(const Args& a, LAS unsigned char* lds, const int wave, const int l, const bf16* Z, const float* GAg, bf16* SB, bf16* SSUP, float* DSUP, bf16* Y) {
    LAS unsigned char* ar = lds + AR;
    const unsigned char* zero_page = a.ws + WS_CTL + 512 * 1024;
    for (int w = blockIdx.x; w < NSUPER * 4; w += gridDim.x) {
        const int sc = w >> 2, s = w & 3;
#pragma unroll 1
        for (int k = 0; k < 3; ++k) { int which = k + (w % 3); which = which >= 3 ? which - 3 : which;
            if (which == 2) mix_head<true, M3>(a, ar, wave, l, sc, s, Z, GAg, zero_page, SB, SSUP, DSUP, Y);
            else mix_head<false, M3>(a, ar, wave, l, sc, 2 * s + which, Z, GAg, zero_page, SB, SSUP, DSUP, Y); }
    }
}

__device__ __forceinline__ void scan_phase(const int wave, bf16* SSUP, const float* DSUP) {
    const int lane = pg8::fresh_lane(), tid = wave * 64 + lane;
    for (int e2 = blockIdx.x * 512 + tid; e2 < E_TOTAL / 2; e2 += gridDim.x * 512) {
        const int e = e2 * 2; int ch;
        if (e < 131072) ch = (e >> 14) * 128 + (((e & 16383) >> 11) << 4) + (e & 15); else { const int e3 = e - 131072; ch = 1024 + (e3 >> 15) * 128 + (((e3 & 32767) >> 12) << 4) + (e3 & 15); }
        float S0 = 0.f, S1 = 0.f;
        constexpr int U = 16;
#pragma unroll 1
        for (int cb = 0; cb < NSUPER; cb += U) {
            unsigned d[U]; f32x2v dd[U];
#pragma unroll
            for (int u = 0; u < U; ++u) { d[u] = *(const unsigned*)(SSUP + (size_t)(cb + u) * E_TOTAL + e); dd[u] = *(const f32x2v*)(DSUP + (size_t)(cb + u) * 1536 + ch); }
#pragma unroll
            for (int u = 0; u < U; ++u) {
                *(unsigned*)(SSUP + (size_t)(cb + u) * E_TOTAL + e) = pk(S0, S1);
                S0 = dd[u][0] * S0 + pg8::bf_lo(d[u]); S1 = dd[u][1] * S1 + pg8::bf_hi(d[u]); }
        }
    }
}
}

template <int DV>
__device__ __forceinline__ void naive_scan_batch(const LAS float* q, const LAS float* f, const LAS float* k, const LAS float* v, float (&S)[128], float* obuf_col, int t0, int col) {
#pragma unroll 1
    for (int tt = 0; tt < 16; ++tt) {
        const float vv = v[tt * DV + col]; float o = 0.f;
#pragma unroll
        for (int c = 0; c < 128; c += 4) {
            const f32x4 ff = *(const LAS f32x4*)(f + tt * 128 + c), kk = *(const LAS f32x4*)(k + tt * 128 + c), qq = *(const LAS f32x4*)(q + tt * 128 + c);
#pragma unroll
            for (int j = 0; j < 4; ++j) { S[c + j] = ff[j] * S[c + j] + kk[j] * vv; o += qq[j] * S[c + j]; }
        }
        obuf_col[(size_t)(t0 + tt) * 2048] = o;
    }
}
__device__ __forceinline__ void naive_recurrence(const Args& a, Frame& F, int l, const bf16* Z, const float* GA, float* OBUF) {
    const int b = blockIdx.x; if (b >= 12) return;
    LAS float* q = (LAS float*)(F.lds); LAS float* f = q + 16 * 128; LAS float* k = f + 16 * 128; LAS float* v = k + 16 * 128;
    LAS float* lbv = v + 16 * 256;
    float S[128];
#pragma unroll
    for (int c = 0; c < 128; ++c) S[c] = 0.f;
    if (b < 8) {
        const int hh = b;
        if (F.tid < 128) { const int ch = hh * 128 + F.tid; float lg[DEPTH], mx = -1e30f;
#pragma unroll
            for (int j = 0; j < DEPTH; ++j) { lg[j] = a.lb_logits[j * HGW + ch]; mx = fmaxf(mx, lg[j]); }
            float den = 0.f, num = 0.f;
#pragma unroll
            for (int j = 0; j < DEPTH; ++j) { const float e = __expf(lg[j] - mx); den += e; if (j >= 1 && j <= l) num += e; }
            lbv[F.tid] = num / den; }
        __syncthreads();
        for (int t0 = 0; t0 < M; t0 += 16) {
#pragma unroll
            for (int i = 0; i < 4; ++i) { const int idx = F.tid + 512 * i, tt = idx >> 7, c = idx & 127; const bf16* zr = Z + (size_t)(t0 + tt) * ZW + hh * 128 + c;
                const float zq = bf2f(zr[ZC_HQ]), zf = bf2f(zr[ZC_HF]), zi = bf2f(zr[ZC_HI]); const float lb = lbv[c];
                const float ff = lb + (1.f - lb) * sigmoidf_(zf);
                q[idx] = zq; f[idx] = ff; k[idx] = 1.f - ff; v[idx] = zi; }
            __syncthreads();
            if (F.tid < 128) naive_scan_batch<128>(q, f, k, v, S, OBUF + hh * 128 + F.tid, t0, F.tid);
            __syncthreads();
        }
    } else {
        const int g = b - 8; const float* cw = a.conv_w + (size_t)l * 4 * CONVC; const float* wg = a.w_gate + (size_t)l * GRANK * GKW; const float* bg = a.b_gate + (size_t)l * GKW;
        for (int t0 = 0; t0 < M; t0 += 16) {
#pragma unroll 1
            for (int i = 0; i < 16; ++i) { const int idx = F.tid + 512 * i, tt = idx >> 9, cc = idx & 511;
                int ch; if (cc < 128) ch = g * 128 + cc; else if (cc < 256) ch = 512 + g * 128 + (cc - 128); else ch = 1024 + g * 256 + (cc - 256);
                const int t = t0 + tt; float s = 0.f;
#pragma unroll
                for (int j = 0; j < 4; ++j) { const int ts = t - 3 + j; if (ts >= 0) s += cw[j * CONVC + ch] * bf2f(Z[(size_t)ts * ZW + ZC_GQ + ch]); }
                s = siluf_(s);
                if (cc < 128) q[tt * 128 + cc] = s * 0.08838834764831845f; else if (cc < 256) k[tt * 128 + cc - 128] = s; else v[tt * 256 + cc - 256] = s; }
#pragma unroll
            for (int i = 0; i < 4; ++i) { const int idx = F.tid + 512 * i, tt = idx >> 7, c = idx & 127; float xg = bg[g * 128 + c];
#pragma unroll
                for (int r = 0; r < GRANK; ++r) xg += GA[(size_t)(t0 + tt) * GRANK + r] * wg[r * GKW + g * 128 + c];
                const float ls = fminf(xg, 0.f) - log1pf(__expf(-fabsf(xg)));
                f[idx] = __expf(ls * (1.0f / 16.0f)); }
            __syncthreads();
            if (F.tid < 256) naive_scan_batch<256>(q, f, k, v, S, OBUF + 1024 + g * 256 + F.tid, t0, F.tid);
            __syncthreads();
        }
    }
}
__device__ __forceinline__ void norm_gate_phase(const Args& a, Frame& F, int l, const bf16* Z, const float* OBUF, bf16* Y) {
    const float* ghg = a.g_hg + (size_t)l * HGW; const float* ggl = a.g_gla + (size_t)l * GLAW;
    for (int t = F.gw; t < M; t += F.NGW) {
        const float* orow = OBUF + (size_t)t * 2048; const bf16* zr = Z + (size_t)t * ZW; bf16* yr = Y + (size_t)t * 2048;
#pragma unroll 1
        for (int hh = 0; hh < HGH; ++hh) { const int c = hh * 128 + 2 * F.lane; const float o0 = orow[c], o1 = orow[c + 1];
            const float ms = wave_sum(o0 * o0 + o1 * o1) * (1.0f / 128.0f); const float r = __builtin_amdgcn_rsqf(ms + EPS);
            const float g0 = bf2f(zr[ZC_HG + c]), g1 = bf2f(zr[ZC_HG + c + 1]);
            *(unsigned*)(yr + c) = pk2(o0 * r * ghg[c] * siluf_(g0), o1 * r * ghg[c + 1] * siluf_(g1)); }
#pragma unroll 1
        for (int g = 0; g < GH; ++g) { const int c = g * 256 + 4 * F.lane; float o[4], ss = 0.f;
#pragma unroll
            for (int j = 0; j < 4; ++j) { o[j] = orow[1024 + c + j]; ss += o[j] * o[j]; }
            const float ms = wave_sum(ss) * (1.0f / 256.0f); const float r = __builtin_amdgcn_rsqf(ms + EPS); float y[4];
#pragma unroll
            for (int j = 0; j < 4; ++j) y[j] = o[j] * r * ggl[c + j] * siluf_(bf2f(zr[ZC_GR + c + j]));
            v2u w; w.x = pk2(y[0], y[1]); w.y = pk2(y[2], y[3]); *(v2u*)(yr + 1024 + c) = w; }
    }
}
__device__ __forceinline__ void final_norm(const Args& a, Frame& F, const float* stats, const bf16* hb) {
    const GAS f32x4* gr = (const GAS f32x4*)a.g_final;
    f32x4 g0[4], g1[4];
#pragma unroll
    for (int j = 0; j < 4; ++j) { const int c4 = (64 * j + F.lane) * 2; g0[j] = gr[c4]; g1[j] = gr[c4 + 1]; }
    for (int m = F.gw; m < M; m += F.NGW) {
        GAS f32x4* orow = (GAS f32x4*)(a.out + (size_t)m * D);
        v4u h[4];
#pragma unroll
        for (int j = 0; j < 4; ++j) h[j] = *(const GAS v4u*)(hb + pg8::tile_rc(m, 8 * (F.lane + 64 * j), D));
        float sv = (F.lane < 32) ? stats[(size_t)m * 32 + F.lane] : 0.f; sv = wave_sum(sv);
        const float rstd = __builtin_amdgcn_rsqf(sv * (1.0f / D) + EPS);
#pragma unroll
        for (int j = 0; j < 4; ++j) { const int c4 = (64 * j + F.lane) * 2;
            const f32x4 o0 = {pg8::bf_lo(h[j].x), pg8::bf_hi(h[j].x), pg8::bf_lo(h[j].y), pg8::bf_hi(h[j].y)}, o1 = {pg8::bf_lo(h[j].z), pg8::bf_hi(h[j].z), pg8::bf_lo(h[j].w), pg8::bf_hi(h[j].w)};
            orow[c4] = o0 * rstd * g0[j]; orow[c4 + 1] = o1 * rstd * g1[j]; }
    }
}
__device__ __forceinline__ int fresh_bx() { int b = blockIdx.x; asm volatile("" : "+s"(b)); return b; }
constexpr int PH_PER_LAYER = 8;
constexpr int N_PHASES = 1 + DEPTH * PH_PER_LAYER + 1;

__global__ void __launch_bounds__(NWAVES * 64, 2) hyb_fwd(Args args) {
    extern __shared__ __attribute__((aligned(16))) unsigned char lds[];
    const int wave_s = __builtin_amdgcn_readfirstlane((int)threadIdx.x >> 6);
#define MKFRAME() Frame F; { F.lds = (LAS unsigned char*)lds; F.lane = pg8::fresh_lane(); F.wave = wave_s; F.tid = wave_s * 64 + F.lane; \
        F.G = gridDim.x; F.gw = blockIdx.x * NWAVES + F.wave; F.NGW = F.G * NWAVES; }
    LAS unsigned char* const ldsb = (LAS unsigned char*)lds;
    LAS float* const RTAB = (LAS float*)(ldsb + RTAB_OFF);
    volatile LAS unsigned* MISC = (volatile LAS unsigned*)(ldsb + MISC_OFF);
    for (int u = threadIdx.x; u < LDSCTL_BYTES / 4; u += NWAVES * 64) ((LAS unsigned*)(ldsb + LDSCTL_OFF))[u] = 0u;
    __syncthreads();
#define BARW ((unsigned*)(args.ws + WS_CTL) + CW_BAR)
    XcdBarrier bar; bar.bar = nullptr; bar.x = 0; bar.st = nullptr;
    const int lo = args.ph_lo, hi = args.ph_hi;

    if (hi - lo > 1) { bar = xcd_barrier_post(BARW, MISC + 8); bar.bar = nullptr; }
#define IN(k) (lo <= (k) && (k) < hi)
#define SEAM(k) do { if (IN(k) && IN((k) + 1)) { xcd_barrier(bar, BARW); for (int pb_ = 0; pb_ < PROBE_BAR; ++pb_) xcd_barrier(bar, BARW); } } while (0)

    if (IN(0)) { MKFRAME(); for (int pr_ = 0; pr_ <= PROBE_PRO; ++pr_) prologue(args, F); SEAM(0); }

#define PH_PTRS() GAS unsigned char* wsg_ = (GAS unsigned char*)args.ws; asm volatile("" : "+s"(wsg_)); unsigned char* ws = (unsigned char*)wsg_;     \
    float* const st_mix = (float*)(ws + WS_STATS); float* const st_mlp = (float*)(ws + WS_STATS + STATS_BYTES); float* const st_ple = (float*)(ws + WS_STATS + 2 * STATS_BYTES); \
    bf16* const Z = (bf16*)(ws + WS_UNION + UO_Z); bf16* const ABUF = (bf16*)(ws + WS_UNION + UO_A); bf16* const PP = (bf16*)(ws + WS_UNION + UO_PP); unsigned char* const H8 = ws + WS_UNION + UO_H8; \
    float* const GA = (float*)(ws + WS_GA); bf16* const PB = (bf16*)(ws + WS_PB); \
    bf16* const SB = (bf16*)(ws + WS_UNION + UO_S); bf16* const SSUP = (bf16*)(ws + WS_UNION + UO_SSUP); float* const DSUP = (float*)(ws + WS_DEC); \
    bf16* const hb = (bf16*)(ws + ((l & 1) ? WS_HBB : WS_HBA)); bf16* const yb = (bf16*)(ws + ((l & 1) ? WS_HBA : WS_HBB)); \
    unsigned char* const wl = ws + WS_W + (size_t)l * W_LAYER; \
    (void)H8; (void)st_mix; (void)st_mlp; (void)st_ple; (void)Z; (void)ABUF; (void)PP; (void)GA; (void)PB; (void)SB; (void)SSUP; (void)DSUP; (void)hb; (void)yb; (void)wl;

#pragma unroll 1
    for (int l = 0; l < DEPTH; ++l) {
        const int pbase = 1 + l * PH_PER_LAYER;

        if (IN(pbase + 0)) { PH_PTRS();
            pg8::Gemm g{hb, (const bf16*)(wl + WO_IN), M, ZW, D}; pg8::StaticOrder S; S.init(M, ZW, (int)gridDim.x, fresh_bx());
            pg8::EpiScaleBf16<0, true> E{Z, ZW, st_mix, RTAB};
            for (int pr_ = 0; pr_ < PROBE_GEMM; ++pr_) { pg8::EpiNull EN; pg8::gemm_phase<pg8::EpiNull, pg8::StaticOrder, PG8_ALIGN, PG8_SP2>(ldsb + RING_OFF, wave_s, g, S, EN); }
            for (int pq_ = 0; pq_ <= PROBE_GEMMR; ++pq_) pg8::gemm_phase<pg8::EpiScaleBf16<0, true>, pg8::StaticOrder, PG8_ALIGN, PG8_SP2, false, true>(ldsb + RING_OFF, wave_s, g, S, E);
            { MKFRAME(); ga_phase(args, F, hb, (const bf16*)(wl + WO_GA), st_mix, GA); }
            SEAM(pbase + 0);
        }
        if (IN(pbase + 1)) { PH_PTRS(); { MKFRAME(); pb_phase(args, F, l); } for (int pr_ = 0; pr_ <= PROBE_MIX; ++pr_) mx::mix_phase<false>(args, ldsb, wave_s, l, Z, GA, SB, SSUP, DSUP, yb); SEAM(pbase + 1); }
        if (IN(pbase + 2)) { PH_PTRS(); mx::scan_phase(wave_s, SSUP, DSUP); SEAM(pbase + 2); }
        if (IN(pbase + 3)) { PH_PTRS(); for (int pr_ = 0; pr_ <= PROBE_MIX; ++pr_) mx::mix_phase<true>(args, ldsb, wave_s, l, Z, GA, SB, SSUP, DSUP, yb); SEAM(pbase + 3); }
        if (IN(pbase + 4)) { PH_PTRS();
            pg8::Gemm g{yb, (const bf16*)(wl + WO_OUT), M, D, D}; pg8::StaticOrder S; S.init(M, D, (int)gridDim.x, fresh_bx());
            pg8::EpiResidual<0> E{hb, hb, st_mlp, nullptr, nullptr, D, RTAB, nullptr};
            for (int pr_ = 0; pr_ < PROBE_GEMM; ++pr_) { pg8::EpiNull EN; pg8::gemm_phase<pg8::EpiNull, pg8::StaticOrder, PG8_ALIGN, PG8_SP2>(ldsb + RING_OFF, wave_s, g, S, EN); }
            pg8::gemm_phase<pg8::EpiResidual<0>, pg8::StaticOrder, PG8_ALIGN, PG8_SP2, false, true>(ldsb + RING_OFF, wave_s, g, S, E);
            SEAM(pbase + 4);
        }
        if (IN(pbase + 5)) { PH_PTRS();
            { pg8::Gemm g{hb, (const bf16*)(wl + WO_UP), M, FF, D}; pg8::StaticOrder S; S.init(M, FF, (int)gridDim.x, fresh_bx());
              pg8::EpiScaleBf16<1, true> E{ABUF, FF, st_mlp, RTAB};
              for (int pr_ = 0; pr_ < PROBE_GEMM; ++pr_) { pg8::EpiNull EN; pg8::gemm_phase<pg8::EpiNull, pg8::StaticOrder, PG8_ALIGN, PG8_SP2>(ldsb + RING_OFF, wave_s, g, S, EN); }
            for (int pq_ = 0; pq_ <= PROBE_GEMMR; ++pq_) pg8::gemm_phase<pg8::EpiScaleBf16<1, true>, pg8::StaticOrder, PG8_ALIGN, PG8_SP2, false, true>(ldsb + RING_OFF, wave_s, g, S, E); }
            SEAM(pbase + 5);
        }
        if (IN(pbase + 6)) { PH_PTRS();
            pg8::Gemm g{ABUF, (const bf16*)(wl + WO_DN), M, D, FF}; pg8::StaticOrder S; S.init(M, D, (int)gridDim.x, fresh_bx(), 4);
            pg8::EpiResidual<2> E{hb, hb, st_ple, nullptr, nullptr, D, RTAB, H8};
            for (int pr_ = 0; pr_ < PROBE_GEMM; ++pr_) { pg8::EpiNull EN; pg8::gemm_phase<pg8::EpiNull, pg8::StaticOrder, PG8_ALIGN, PG8_SP2>(ldsb + RING_OFF, wave_s, g, S, EN); }
            pg8::gemm_phase<pg8::EpiResidual<2>, pg8::StaticOrder, PG8_ALIGN, PG8_SP2, false, true>(ldsb + RING_OFF, wave_s, g, S, E);
            SEAM(pbase + 6);
        }
        if (IN(pbase + 7)) { PH_PTRS();
            { pg8::Gemm g{PB, (const bf16*)(wl + WO_PP), M, D, PLE}; pg8::StaticOrder S; S.init(M, D, (int)gridDim.x, fresh_bx());
              pg8::EpiScaleBf16<2, true> E{PP, D, nullptr, RTAB};
              for (int pr_ = 0; pr_ < PROBE_GEMM; ++pr_) { pg8::EpiNull EN; pg8::gemm_phase<pg8::EpiNull, pg8::StaticOrder, PG8_ALIGN, PG8_SP2>(ldsb + RING_OFF, wave_s, g, S, EN); }
            for (int pq_ = 0; pq_ <= PROBE_GEMMR; ++pq_) pg8::gemm_phase<pg8::EpiScaleBf16<2, true>, pg8::StaticOrder, PG8_ALIGN, PG8_SP2>(ldsb + RING_OFF, wave_s, g, S, E); }
            pg8::Gemm g{(const bf16*)H8, (const bf16*)(wl + WO_PG), M, D, D / 2}; pg8::StaticOrder S; S.init(M, D, (int)gridDim.x, fresh_bx());
            pg8::EpiResidual<1> E{hb, yb, st_mix, st_ple, PP, D, RTAB, nullptr};
            for (int pr_ = 0; pr_ < PROBE_GEMM; ++pr_) { pg8::EpiNull EN; pg8::gemm_phase<pg8::EpiNull, pg8::StaticOrder, PG8_ALIGN, PG8_SP2, true>(ldsb + RING_OFF, wave_s, g, S, EN); }
            int np5_ = PROBE_G5 + 1; asm volatile("" : "+s"(np5_));
#pragma unroll 1
            for (int pq_ = 0; pq_ < np5_; ++pq_) pg8::gemm_phase<pg8::EpiResidual<1>, pg8::StaticOrder, PG8_ALIGN, PG8_SP2, true, true>(ldsb + RING_OFF, wave_s, g, S, E);
            SEAM(pbase + 7);
        }
    }
    if (IN(N_PHASES - 1)) { const int l = DEPTH; PH_PTRS(); MKFRAME(); final_norm(args, F, st_mix, hb); }

#undef IN
#undef SEAM
}

extern "C" void kernel_launch(void* const* d_in, const int* in_sizes, int n_in, void* d_out, int out_size, void* d_ws, size_t ws_size, hipStream_t stream) {
    static int grid = 0;
    if (grid == 0) {
        if (n_in != 18 || out_size != M * D || ws_size < WS_END) { fprintf(stderr, "kernel_launch: unexpected shapes (n_in %d out %d ws %zu, need %zu); nothing launched\n", n_in, out_size, ws_size, (size_t)WS_END); grid = -1; return; }
        int dev = 0, cus = 0, per_cu = 0;
        if (hipGetDevice(&dev) != hipSuccess || hipDeviceGetAttribute(&cus, hipDeviceAttributeMultiprocessorCount, dev) != hipSuccess) { grid = -1; return; }
        if (hipFuncSetAttribute((const void*)hyb_fwd, hipFuncAttributeMaxDynamicSharedMemorySize, LDS_BYTES) != hipSuccess) { fprintf(stderr, "kernel_launch: hipFuncSetAttribute failed\n"); grid = -1; return; }
        if (hipOccupancyMaxActiveBlocksPerMultiprocessor(&per_cu, (const void*)hyb_fwd, NWAVES * 64, LDS_BYTES) != hipSuccess || per_cu < 1) { fprintf(stderr, "kernel_launch: occupancy query says %d\n", per_cu); }
        (void)hipGetLastError();
        grid = cus;
    }
    if (grid < 0) return;
    if (hipMemsetAsync((char*)d_ws + WS_CTL, 0, CTL_ZERO_BYTES, stream) != hipSuccess) return;
    Args a{};
    const float** pa = (const float**)&a;
    for (int i = 0; i < 18; ++i) pa[i] = (const float*)d_in[i];
    a.out = (float*)d_out; a.ws = (unsigned char*)d_ws;
#if MK_MULTI
    for (int ph = 0; ph < N_PHASES; ++ph) { a.ph_lo = ph; a.ph_hi = ph + 1; hipLaunchKernelGGL(hyb_fwd, dim3(grid), dim3(NWAVES * 64), LDS_BYTES, stream, a); }
#else
    a.ph_lo = 0; a.ph_hi = N_PHASES;
    hipLaunchKernelGGL(hyb_fwd, dim3(grid), dim3(NWAVES * 64), LDS_BYTES, stream, a);
#endif
}
```

```cpp
#include <hip/hip_runtime.h>
#include <cstdio>
#include <cstdint>

#ifndef PROBE_GEMM
#define PROBE_GEMM 0
#endif
#ifndef PROBE_MIX
#define PROBE_MIX 0
#endif
#ifndef PROBE_BAR
#define PROBE_BAR 0
#endif
#ifndef PROBE_SCAN
#define PROBE_SCAN 0
#endif
#ifndef PROBE_GEMMR
#define PROBE_GEMMR 0
#endif
#ifndef PROBE_PRO
#define PROBE_PRO 0
#endif
#ifndef PROBE_G5
#define PROBE_G5 0
#endif
#ifndef MK_MULTI
#define MK_MULTI 0
#endif

namespace pg8 {
#define PG8_LAS __attribute__((address_space(3)))
typedef unsigned short bf16_t;
typedef short bf16x8 __attribute__((ext_vector_type(8)));
typedef float f32x4 __attribute__((ext_vector_type(4)));
typedef unsigned u32x4 __attribute__((ext_vector_type(4)));
typedef unsigned u32x2 __attribute__((ext_vector_type(2)));
constexpr int BM = 256, BK = 64, HALF = 128, HTB = HALF * BK * 2  , STAGE_BYTES = 8 * HTB, NXCD = 8, WGM = 8;

__host__ __device__ __forceinline__ int lds_byte(int r, int c) { const int st = (r >> 4) * 2 + (c >> 5), rr = r & 15, cc = c & 31, ob = rr * 64 + cc * 2; return st * 1024 + (ob ^ (((ob >> 9) & 1) << 5)); }
__host__ __device__ __forceinline__ void stage_rc(int b, int& R, int& C) { const int st = b / 1024, sb = b % 1024, swz = sb ^ (((sb >> 9) & 1) << 5); R = (st >> 1) * 16 + swz / 64; C = (st & 1) * 32 + (swz % 64) / 2; }
__host__ __device__ __forceinline__ int perm32(int rho) { const int n = rho >> 4, i = rho & 15; return 8 * (i >> 2) + 4 * n + (i & 3); }

struct Unit { int pm, pn; };
struct Gemm { const bf16_t* A; const bf16_t* Bt; int M, N, K; };

struct StaticOrder {
    int nM, nN, nwg, G, c, wgm;
    __host__ __device__ void init(int M, int N, int G_, int c_, int wgm_ = WGM) { nM = M / BM; nN = N / BM; nwg = nM * nN; G = G_; c = c_; wgm = wgm_; }
    __host__ __device__ bool next(int i, Unit& u) const {
        const long L = (long)i * G + c; if (L >= nwg) return false;
        int wgid = (int)L; { const int q = nwg / NXCD, r = nwg % NXCD, xcd = wgid % NXCD, off = wgid / NXCD; wgid = (xcd < r ? xcd * (q + 1) : r * (q + 1) + (xcd - r) * q) + off; }
        const int nig = wgm * nN, gid = wgid / nig, fm = gid * wgm, gsz = (nM - fm) < wgm ? (nM - fm) : wgm;
        u.pm = fm + ((wgid % nig) % gsz); u.pn = (wgid % nig) / gsz; return true;
    }
    __device__ __forceinline__ void a_ready(const Unit&) const {}
    __device__ __forceinline__ void done(const Unit&) const {}
};

typedef __bf16 bf16x2_t __attribute__((ext_vector_type(2)));
typedef float f32x2_t __attribute__((ext_vector_type(2)));
__device__ __forceinline__ unsigned cvt_pk_bf16(float lo, float hi) { const f32x2_t f = {lo, hi}; const bf16x2_t b = __builtin_convertvector(f, bf16x2_t); return __builtin_bit_cast(unsigned, b); }
__device__ __forceinline__ float bf_lo(unsigned w) { return __uint_as_float(w << 16); }
__device__ __forceinline__ float bf_hi(unsigned w) { return __uint_as_float(w & 0xffff0000u); }
__device__ __forceinline__ unsigned cvt_pk_fp8x4(float a, float b, float c, float d) { int w = 0; w = __builtin_amdgcn_cvt_pk_fp8_f32(a, b, w, false); w = __builtin_amdgcn_cvt_pk_fp8_f32(c, d, w, true); return (unsigned)w; }
typedef int i32x4_t __attribute__((ext_vector_type(4)));
typedef int i32x8_t __attribute__((ext_vector_type(8)));
__device__ __forceinline__ i32x8_t cat8(bf16x8 lo, bf16x8 hi) { const i32x4_t a = __builtin_bit_cast(i32x4_t, lo), b = __builtin_bit_cast(i32x4_t, hi); return __builtin_shufflevector(a, b, 0, 1, 2, 3, 4, 5, 6, 7); }
__device__ __forceinline__ float sum_xor16(float v) { const unsigned b = __builtin_bit_cast(unsigned, v); const auto r = __builtin_amdgcn_permlane16_swap(b, b, false, false); return __builtin_bit_cast(float, (unsigned)r[0]) + __builtin_bit_cast(float, (unsigned)r[1]); }
__device__ __forceinline__ float sum_xor32(float v) { const unsigned b = __builtin_bit_cast(unsigned, v); const auto r = __builtin_amdgcn_permlane32_swap(b, b, false, false); return __builtin_bit_cast(float, (unsigned)r[0]) + __builtin_bit_cast(float, (unsigned)r[1]); }
template <int CTRL> __device__ __forceinline__ float dpp_get(float v) { return __builtin_bit_cast(float, __builtin_amdgcn_mov_dpp(__builtin_bit_cast(int, v), CTRL, 0xF, 0xF, true)); }
__device__ __forceinline__ float get_xor1(float v) { return __builtin_bit_cast(float, __builtin_amdgcn_mov_dpp(__builtin_bit_cast(int, v), 0xB1, 0xF, 0xF, true)); }
constexpr float F8_WSCALE = 64.0f;

constexpr float RMS_EPS = 1e-6f;
constexpr int DMODEL = 2048;
constexpr int NSTAT = 32;

__device__ __forceinline__ void rstd_table(const float* stats, int pm, int wid, int lane, PG8_LAS float* tab) {
    const int t = wid * 64 + lane, row = t >> 1, half = t & 1;
    const f32x4* p = (const f32x4*)(stats + (size_t)(pm * BM + row) * NSTAT + half * 16);
    const f32x4 a = p[0], b = p[1], c = p[2], d = p[3];
    float s = (((a[0] + a[1]) + (a[2] + a[3])) + ((b[0] + b[1]) + (b[2] + b[3]))) + (((c[0] + c[1]) + (c[2] + c[3])) + ((d[0] + d[1]) + (d[2] + d[3])));
    s += get_xor1(s);
    if (half == 0) tab[row] = __builtin_amdgcn_rsqf(s * (1.0f / DMODEL) + RMS_EPS);
}

__host__ __device__ __forceinline__ size_t tile_rc(int row, int col, int ld) { return (((size_t)(row >> 4) * (ld >> 5) + (col >> 5)) << 9) + (row & 15) * 32 + (col & 31); }
__device__ __forceinline__ size_t tiled_off(int row, int ldc, int pn, int wc, int bj, int fq) { return (((size_t)(row >> 4) * (ldc >> 5) + pn * 8 + wc + bj * 4) << 9) + (row & 15) * 32 + 8 * fq; }
template <int ACT, bool TILED = false> struct EpiScaleBf16 {
    static constexpr bool PERM = true, AFTER_DRAIN = false;
    bf16_t* O; int ldc; const float* stats; PG8_LAS float* tab;
    __device__ __forceinline__ void prepare(const Unit& u, int wid, int lane, int par) const { if (ACT != 2) rstd_table(stats, u.pm, wid, lane, tab + par * 256); }
    __device__ __forceinline__ void operator()(const f32x4 (&acc)[2][2][4][2], const Unit& u, int wr, int wc, int fr, int fq, int wid, int lane, int par) const {
        const int rl0 = wr * 64 + fr, col0 = u.pn * BM + wc * 32 + 8 * fq;
#pragma unroll
        for (int ai = 0; ai < 2; ++ai)
#pragma unroll
            for (int m = 0; m < 4; ++m) { const int rl = rl0 + ai * HALF + m * 16; bf16_t* rowp = O + (size_t)(u.pm * BM + rl) * ldc + col0;
                float sc = 1.0f; if (ACT != 2) sc = tab[par * 256 + rl];
#pragma unroll
                for (int bj = 0; bj < 2; ++bj) { f32x4 v0 = acc[ai][bj][m][0] * sc, v1 = acc[ai][bj][m][1] * sc;
                    if (ACT == 1) {
#pragma unroll
                        for (int j = 0; j < 4; ++j) { const float a0 = fmaxf(v0[j], 0.f), a1 = fmaxf(v1[j], 0.f); v0[j] = a0 * a0; v1[j] = a1 * a1; } }
                    u32x4 w; w.x = cvt_pk_bf16(v0[0], v0[1]); w.y = cvt_pk_bf16(v0[2], v0[3]); w.z = cvt_pk_bf16(v1[0], v1[1]); w.w = cvt_pk_bf16(v1[2], v1[3]);
                    if constexpr (TILED) {
                        const int row = u.pm * BM + rl;
                        *(u32x4*)(O + (((size_t)(row >> 4) * (ldc >> 5) + u.pn * 8 + wc + bj * 4) << 9) + (row & 15) * 32 + 8 * fq) = w;
                    } else *(u32x4*)(rowp + bj * HALF) = w; } }
    }
};

template <int MODE> struct EpiResidual {
    static constexpr bool PERM = true, AFTER_DRAIN = false;
    const bf16_t* hin; bf16_t* hout; float* stats_out; const float* stats_in; const bf16_t* pp; int ldc; PG8_LAS float* tab; unsigned char* h8;
    __device__ __forceinline__ void prepare(const Unit& u, int wid, int lane, int par) const { if (MODE == 1) rstd_table(stats_in, u.pm, wid, lane, tab + par * 256); }
    __device__ __forceinline__ void operator()(const f32x4 (&acc)[2][2][4][2], const Unit& u, int wr, int wc, int fr, int fq, int wid, int lane, int par) const {
        const int rl0 = wr * 64 + fr, col0 = u.pn * BM + wc * 32 + 8 * fq;
#pragma unroll
        for (int ai = 0; ai < 2; ++ai) {
            u32x4 hv[4][2], pw[4][2];
#pragma unroll
            for (int m = 0; m < 4; ++m) { const size_t off = (size_t)(u.pm * BM + rl0 + ai * HALF + m * 16) * ldc + col0;
#pragma unroll
                for (int bj = 0; bj < 2; ++bj) { hv[m][bj] = *(const u32x4*)(hin + tiled_off(u.pm * BM + rl0 + ai * HALF + m * 16, ldc, u.pn, wc, bj, fq)); if (MODE == 1) pw[m][bj] = *(const u32x4*)(pp + tiled_off(u.pm * BM + rl0 + ai * HALF + m * 16, ldc, u.pn, wc, bj, fq)); } }
#pragma unroll
            for (int m = 0; m < 4; ++m) { const int rl = rl0 + ai * HALF + m * 16, row = u.pm * BM + rl; const size_t off = (size_t)row * ldc + col0; float ss = 0.f;
                float sc2 = 0.f; if (MODE == 1) sc2 = tab[par * 256 + rl] * (-1.4426950408889634f / F8_WSCALE);
#pragma unroll
                for (int bj = 0; bj < 2; ++bj) {
                    f32x4 v0 = acc[ai][bj][m][0], v1 = acc[ai][bj][m][1];
                    if (MODE == 1) {
                        const u32x4 q = pw[m][bj];
                        const float pv[8] = {bf_lo(q.x), bf_hi(q.x), bf_lo(q.y), bf_hi(q.y), bf_lo(q.z), bf_hi(q.z), bf_lo(q.w), bf_hi(q.w)};
#pragma unroll
                        for (int j = 0; j < 4; ++j) {
                            const float g0 = __builtin_amdgcn_rcpf(1.0f + __builtin_amdgcn_exp2f(v0[j] * sc2)), g1 = __builtin_amdgcn_rcpf(1.0f + __builtin_amdgcn_exp2f(v1[j] * sc2));
                            v0[j] = g0 * pv[j]; v1[j] = g1 * pv[4 + j]; }
                    }
                    const u32x4 h = hv[m][bj];
                    v0 = v0 + (f32x4){bf_lo(h.x), bf_hi(h.x), bf_lo(h.y), bf_hi(h.y)}; v1 = v1 + (f32x4){bf_lo(h.z), bf_hi(h.z), bf_lo(h.w), bf_hi(h.w)};
                    u32x4 w; w.x = cvt_pk_bf16(v0[0], v0[1]); w.y = cvt_pk_bf16(v0[2], v0[3]); w.z = cvt_pk_bf16(v1[0], v1[1]); w.w = cvt_pk_bf16(v1[2], v1[3]);
                    *(u32x4*)(hout + tiled_off(row, ldc, u.pn, wc, bj, fq)) = w;
                    if (MODE == 2) { u32x2 w8; w8.x = cvt_pk_fp8x4(v0[0], v0[1], v0[2], v0[3]); w8.y = cvt_pk_fp8x4(v1[0], v1[1], v1[2], v1[3]); const int bc = u.pn * BM + bj * HALF + wc * 32 + 8 * fq;
                        *(u32x2*)(h8 + ((((size_t)(row >> 4) * (ldc >> 6)) + (bc >> 6)) << 10) + (row & 15) * 64 + (bc & 63)) = w8; }
                    ss += (v0[0] * v0[0] + v0[1] * v0[1]) + (v0[2] * v0[2] + v0[3] * v0[3]) + (v1[0] * v1[0] + v1[1] * v1[1]) + (v1[2] * v1[2] + v1[3] * v1[3]);
                }
                ss = sum_xor16(ss); ss = sum_xor32(ss);
                if (fq == 0) stats_out[(size_t)row * NSTAT + u.pn * 4 + wc] = ss;
            }
            asm volatile("" ::: "memory");
        }
    }
};

struct EpiNull { static constexpr bool PERM = true, AFTER_DRAIN = false;
    __device__ __forceinline__ void prepare(const Unit&, int, int, int) const {}
    __device__ __forceinline__ void operator()(const f32x4 (&acc)[2][2][4][2], const Unit&, int, int, int, int, int, int, int) const {
#pragma unroll
        for (int a = 0; a < 2; ++a)
#pragma unroll
            for (int b = 0; b < 2; ++b)
#pragma unroll
                for (int m = 0; m < 4; ++m)
#pragma unroll
                    for (int n = 0; n < 2; ++n) asm volatile("" :: "v"(acc[a][b][m][n])); } };
__device__ __forceinline__ int fresh_lane() { int l; asm volatile("v_mbcnt_lo_u32_b32 %0, -1, 0\n\tv_mbcnt_hi_u32_b32 %0, -1, %0" : "=v"(l)); return l; }
template <class Epi, class Sched, bool ALIGN_EPI = false, bool SP2 = false, bool FP8 = false, bool ATILED = false, bool BTILED = true>
__device__ __forceinline__ void gemm_phase(PG8_LAS unsigned char* lds, const int wid_in, const Gemm g, const Sched& S, const Epi& E) {
    int wid = wid_in; asm volatile("" : "+s"(wid));
    const int lane = fresh_lane(), tid = wid * 64 + lane, wr = wid >> 2, wc = wid & 3, fr = lane & 15, fq = lane >> 4;
    const int K = g.K, nt = K / BK;
    unsigned voffA[2], voffB[2];
#pragma unroll
    for (int i = 0; i < 2; ++i) { int R, C; stage_rc(tid * 16 + i * 8192, R, C); const int Rb = Epi::PERM ? ((R & ~31) + perm32(R & 31)) : R;
        voffA[i] = ATILED ? (unsigned)((((R >> 4) * (K >> 5) + (C >> 5)) << 10) + (R & 15) * 64 + (C & 31) * 2) : (unsigned)(R * K + C) * 2u; voffB[i] = BTILED ? (unsigned)((((R >> 4) * (K >> 5) + (C >> 5)) << 10) + (R & 15) * 64 + (C & 31) * 2) : (unsigned)(Rb * K + C) * 2u; }
    const size_t kstep = (size_t)(BK * 2);
    const size_t kstepA = ATILED ? (size_t)2048 : kstep;
    const size_t kstepB = BTILED ? (size_t)2048 : kstep;
    const size_t hstep = (size_t)HALF * K * 2;
    const size_t tstep = 2 * hstep;
    const unsigned ldsw = (unsigned)wid * 1024u;
    const int aoff = lds_byte(wr * 64 + fr, fq * 8), boff = lds_byte(wc * 32 + fr, fq * 8);
#define PG8_SA(b, h) (((b) * 2 + (h)) * HTB)
#define PG8_SB(b, h) ((4 + (b) * 2 + (h)) * HTB)
#define PG8_STAGE(bufoff, gbase, voff) do { _Pragma("unroll") for (int _i = 0; _i < 2; ++_i) { unsigned _vo = (voff)[_i]; if constexpr (FP8) asm volatile("" : "+v"(_vo));    \
        __builtin_amdgcn_global_load_lds((const unsigned*)((const char*)(gbase) + _vo), (PG8_LAS unsigned*)(lds + (bufoff) + ldsw + _i * 8192), 16, 0, 0); } } while (0)
#define PG8_LDA(dst, b, h) do { _Pragma("unroll") for (int m = 0; m < 4; ++m) _Pragma("unroll") for (int k = 0; k < 2; ++k) dst[m][k] = *(const PG8_LAS bf16x8*)(lds + PG8_SA(b, h) + aoff + m * 2048 + k * 1024); } while (0)
#define PG8_LDB(dst, b, h) do { _Pragma("unroll") for (int n = 0; n < 2; ++n) _Pragma("unroll") for (int k = 0; k < 2; ++k) dst[n][k] = *(const PG8_LAS bf16x8*)(lds + PG8_SB(b, h) + boff + n * 2048 + k * 1024); } while (0)
#define PG8_MMA(ai, bj, At, Bt) do { __builtin_amdgcn_s_setprio(1); _Pragma("unroll") for (int m = 0; m < 4; ++m) _Pragma("unroll") for (int n = 0; n < 2; ++n) { \
        if constexpr (FP8) acc[ai][bj][m][n] = __builtin_amdgcn_mfma_scale_f32_16x16x128_f8f6f4(cat8(Bt[n][0], Bt[n][1]), cat8(At[m][0], At[m][1]), acc[ai][bj][m][n], 0, 0, 0, 0, 0, 0);   \
        else { _Pragma("unroll") for (int k = 0; k < 2; ++k) acc[ai][bj][m][n] = __builtin_amdgcn_mfma_f32_16x16x32_bf16(Bt[n][k], At[m][k], acc[ai][bj][m][n], 0, 0, 0); } } \
        __builtin_amdgcn_s_setprio(0); } while (0)
#define PG8_WAIT_V(n) asm volatile("s_waitcnt vmcnt(" #n ")" ::: "memory")
#define PG8_WAIT_L(n) asm volatile("s_waitcnt lgkmcnt(" #n ")" ::: "memory")
#define PG8_BAR __builtin_amdgcn_s_barrier()
#define PG8_SCHED __builtin_amdgcn_sched_barrier(0)
    Unit cur, nxt; int ui = 0;
    if (!S.next(0, cur)) return;
    f32x4 acc[2][2][4][2];
#pragma unroll
    for (int a = 0; a < 2; ++a)
#pragma unroll
        for (int b = 0; b < 2; ++b)
#pragma unroll
            for (int m = 0; m < 4; ++m)
#pragma unroll
                for (int n = 0; n < 2; ++n) acc[a][b][m][n] = (f32x4){0.f, 0.f, 0.f, 0.f};
    bf16x8 At[4][2], B0[2][2], B1[2][2];
    const char* cA = (const char*)g.A + (size_t)cur.pm * tstep; const char* cB = (const char*)g.Bt + (size_t)cur.pn * tstep;
    S.a_ready(cur);
    if constexpr (SP2) {
        PG8_STAGE(PG8_SB(0, 0), cB, voffB); PG8_STAGE(PG8_SB(0, 1), cB + hstep, voffB); PG8_STAGE(PG8_SA(0, 0), cA, voffA); PG8_STAGE(PG8_SA(0, 1), cA + hstep, voffA);
        E.prepare(cur, wid, lane, 0);
        if (wr == 1) PG8_BAR;
        PG8_WAIT_V(2); PG8_BAR;
        PG8_STAGE(PG8_SB(1, 0), cB + kstepB, voffB); PG8_STAGE(PG8_SA(1, 0), cA + kstepA, voffA); PG8_STAGE(PG8_SB(1, 1), cB + hstep + kstepB, voffB);
        PG8_WAIT_V(6); PG8_BAR;
    } else {
        PG8_STAGE(PG8_SB(0, 0), cB, voffB); PG8_STAGE(PG8_SA(0, 0), cA, voffA); PG8_STAGE(PG8_SB(0, 1), cB + hstep, voffB); PG8_STAGE(PG8_SA(0, 1), cA + hstep, voffA);
        E.prepare(cur, wid, lane, 0);
        if (wr == 1) PG8_BAR;
        PG8_WAIT_V(4); PG8_BAR;
        PG8_STAGE(PG8_SB(1, 0), cB + kstepB, voffB); PG8_STAGE(PG8_SA(1, 0), cA + kstepA, voffA); PG8_STAGE(PG8_SB(1, 1), cB + hstep + kstepB, voffB);
        PG8_WAIT_V(6); PG8_BAR;
    }
    for (;;) {
        const bool has_next = S.next(ui + 1, nxt);
        const char* nA = has_next ? (const char*)g.A + (size_t)nxt.pm * tstep : cA; const char* nB = has_next ? (const char*)g.Bt + (size_t)nxt.pn * tstep : cB;
#pragma unroll 1
        for (int t = 0; t < nt; t += 2) {
            const bool last = (t == nt - 2);
            const char* a1 = cA + (size_t)(t + 1) * kstepA;
            const char* a2 = last ? nA : cA + (size_t)(t + 2) * kstepA; const char* b2 = last ? nB : cB + (size_t)(t + 2) * kstepB;
            const char* a3 = a2 + kstepA; const char* b3 = b2 + kstepB;
            if (last && has_next) S.a_ready(nxt);
            if constexpr (SP2) {
            PG8_LDB(B0, 0, 0); PG8_LDB(B1, 0, 1); PG8_SCHED; PG8_LDA(At, 0, 0); PG8_STAGE(PG8_SA(1, 1), a1 + hstep, voffA);
            PG8_WAIT_V(8); PG8_WAIT_L(0); PG8_BAR; PG8_MMA(0, 0, At, B0); PG8_MMA(0, 1, At, B1); PG8_BAR; PG8_SCHED;
            PG8_LDA(At, 0, 1); PG8_STAGE(PG8_SB(0, 0), b2, voffB); PG8_STAGE(PG8_SB(0, 1), b2 + hstep, voffB); PG8_STAGE(PG8_SA(0, 0), a2, voffA);
            PG8_WAIT_V(8); PG8_WAIT_L(0); PG8_BAR; PG8_MMA(1, 0, At, B0); PG8_MMA(1, 1, At, B1); PG8_BAR; PG8_SCHED;
            PG8_LDB(B0, 1, 0); PG8_LDB(B1, 1, 1); PG8_SCHED; PG8_LDA(At, 1, 0); PG8_STAGE(PG8_SA(0, 1), a2 + hstep, voffA);
            PG8_WAIT_V(8); PG8_WAIT_L(0); PG8_BAR; PG8_MMA(0, 0, At, B0); PG8_MMA(0, 1, At, B1); PG8_BAR; PG8_SCHED;
            PG8_LDA(At, 1, 1); PG8_STAGE(PG8_SB(1, 0), b3, voffB); PG8_STAGE(PG8_SB(1, 1), b3 + hstep, voffB); PG8_STAGE(PG8_SA(1, 0), a3, voffA);
            PG8_WAIT_V(8); PG8_WAIT_L(0); PG8_BAR; PG8_MMA(1, 0, At, B0); PG8_MMA(1, 1, At, B1); PG8_BAR; PG8_SCHED;
            } else {
            PG8_LDB(B0, 0, 0); PG8_SCHED; PG8_LDA(At, 0, 0); PG8_STAGE(PG8_SA(1, 1), a1 + hstep, voffA);
            PG8_WAIT_L(8); PG8_BAR; PG8_WAIT_L(0); PG8_MMA(0, 0, At, B0); PG8_BAR; PG8_SCHED;
            PG8_LDB(B1, 0, 1); PG8_STAGE(PG8_SB(0, 0), b2, voffB);
            PG8_BAR; PG8_WAIT_L(0); PG8_MMA(0, 1, At, B1); PG8_BAR;
            PG8_LDA(At, 0, 1); PG8_STAGE(PG8_SA(0, 0), a2, voffA);
            PG8_BAR; PG8_WAIT_L(0); PG8_MMA(1, 0, At, B0); PG8_BAR; PG8_SCHED;
            PG8_STAGE(PG8_SB(0, 1), b2 + hstep, voffB);
            PG8_WAIT_V(6); PG8_BAR; PG8_MMA(1, 1, At, B1); PG8_BAR;
            PG8_LDB(B0, 1, 0); PG8_SCHED; PG8_LDA(At, 1, 0); PG8_STAGE(PG8_SA(0, 1), a2 + hstep, voffA);
            PG8_WAIT_L(8); PG8_BAR; PG8_WAIT_L(0); PG8_MMA(0, 0, At, B0); PG8_BAR; PG8_SCHED;
            PG8_LDB(B1, 1, 1); PG8_STAGE(PG8_SB(1, 0), b3, voffB);
            PG8_BAR; PG8_WAIT_L(0); PG8_MMA(0, 1, At, B1); PG8_BAR;
            PG8_LDA(At, 1, 1); PG8_STAGE(PG8_SA(1, 0), a3, voffA);
            PG8_BAR; PG8_WAIT_L(0); PG8_MMA(1, 0, At, B0); PG8_BAR; PG8_SCHED;
            PG8_STAGE(PG8_SB(1, 1), b3 + hstep, voffB);
            PG8_WAIT_V(6); PG8_BAR; PG8_MMA(1, 1, At, B1); PG8_BAR;
            }
        }
        if constexpr (ALIGN_EPI) { if (wr == 0) PG8_BAR; }
        { const int l2 = fresh_lane(); E(acc, cur, wr, wc, l2 & 15, l2 >> 4, wid, l2, ui & 1); } S.done(cur);
        if (!has_next) break;
#pragma unroll
        for (int a = 0; a < 2; ++a)
#pragma unroll
            for (int b = 0; b < 2; ++b)
#pragma unroll
                for (int m = 0; m < 4; ++m)
#pragma unroll
                    for (int n = 0; n < 2; ++n) acc[a][b][m][n] = (f32x4){0.f, 0.f, 0.f, 0.f};
        cur = nxt; cA = nA; cB = nB; ++ui;
        if constexpr (ALIGN_EPI) { if (wr == 1) PG8_BAR; }
        { const int l3 = fresh_lane(); E.prepare(cur, wid, l3, ui & 1); }
    }
    PG8_WAIT_V(0);
    if constexpr (!ALIGN_EPI) { if (wr == 0) PG8_BAR; }
    PG8_BAR;
#undef PG8_SA
#undef PG8_SB
#undef PG8_STAGE
#undef PG8_LDA
#undef PG8_LDB
#undef PG8_MMA
#undef PG8_WAIT_V
#undef PG8_WAIT_L
#undef PG8_BAR
#undef PG8_SCHED
}
}

#ifndef PG8_SP2
#define PG8_SP2 true
#endif
#ifndef PG8_ALIGN
#define PG8_ALIGN true
#endif

constexpr int NWAVES = 8;
constexpr int M = 16384, D = 2048, DEPTH = 4, FF = 8192, INW = 7184, ZW = 7168, PLE = 256;
constexpr int HGW = 1024, HGH = 8, HD = 128;
constexpr int GH = 4, GDK = 128, GDV = 256, GKW = 512, GLAW = 1024, GRANK = 16;
constexpr int ZC_HQ = 0, ZC_HF = 1024, ZC_HI = 2048, ZC_HG = 3072, ZC_GQ = 4096, ZC_GK = 4608, ZC_GV = 5120, ZC_GR = 6144;
constexpr int CONVC = 2048;
constexpr float EPS = 1e-6f;
constexpr int CHUNK = 64, NCHUNK = M / CHUNK;

constexpr size_t MiB = 1u << 20;
constexpr size_t WS_CTL = 0, CTL_ZERO_BYTES = 1 * MiB;
constexpr size_t WS_STATS = 1 * MiB;
constexpr size_t STATS_BYTES = (size_t)M * 32 * 4;
constexpr size_t WS_GA = 7 * MiB;
constexpr size_t WS_DEC = 8 * MiB;
constexpr size_t WS_PB = 12 * MiB;
constexpr size_t WS_HBA = 20 * MiB, WS_HBB = 84 * MiB;
constexpr size_t WS_W = 148 * MiB, W_LAYER = 110 * MiB;
constexpr size_t WO_IN = 0, WO_OUT = 28 * MiB, WO_UP = 36 * MiB, WO_DN = 68 * MiB, WO_PG = 100 * MiB, WO_PP = 108 * MiB, WO_GA = 109 * MiB;
constexpr size_t WS_UNION = 588 * MiB;
constexpr size_t UO_Z = 0, UO_OBUF = 224 * MiB, UO_S = 224 * MiB, UO_SSUP = 352 * MiB, UO_A = 0, UO_PP = 256 * MiB, UO_H8 = 320 * MiB  ;
constexpr size_t WS_END = 972 * MiB;

constexpr int CW_BAR = 4096;

constexpr int RING_OFF = 0, RING_BYTES = 131072;
constexpr int LDS_BYTES = 163840;
constexpr int RTAB_OFF = RING_BYTES;
constexpr int LDSCTL_BYTES = 1024, LDSCTL_OFF = LDS_BYTES - LDSCTL_BYTES, MISC_OFF = LDSCTL_OFF + 320;

#define GAS __attribute__((address_space(1)))
#define LAS __attribute__((address_space(3)))
typedef unsigned short bf16;
typedef unsigned v4u __attribute__((ext_vector_type(4)));
typedef unsigned v2u __attribute__((ext_vector_type(2)));
typedef float f32x4 __attribute__((ext_vector_type(4)));
typedef GAS unsigned gu32;
#define LDS_WAIT() asm volatile("s_waitcnt lgkmcnt(0)" ::: "memory")
#define VM_WAIT() asm volatile("s_waitcnt vmcnt(0)" ::: "memory")
__device__ __forceinline__ unsigned f2bf(float f) { unsigned u = __builtin_bit_cast(unsigned, f); return (u + 0x7fffu + ((u >> 16) & 1u)) >> 16; }
__device__ __forceinline__ unsigned pk2(float lo, float hi) { return f2bf(lo) | (f2bf(hi) << 16); }
__device__ __forceinline__ float bf2f(bf16 b) { return __uint_as_float(((unsigned)b) << 16); }

#define XB_TMO      128
#define XB_XCNT(j)  (256  + 64 * (j))
#define XB_XSUB(j)  (1280 + 64 * (j))
#define XB_XGEN(j)  (2304 + 64 * (j))
#define XB_TOP      3328
#define XB_TOPGEN   3392
#define XCD_BAR_WORDS 3456
#define XB_SPIN_CAP (1u << 20)
__device__ __forceinline__ unsigned xb_ld(unsigned* p)              { return __hip_atomic_load(p, __ATOMIC_RELAXED, __HIP_MEMORY_SCOPE_AGENT); }
__device__ __forceinline__ unsigned xb_add(unsigned* p, unsigned v) { return __hip_atomic_fetch_add(p, v, __ATOMIC_RELAXED, __HIP_MEMORY_SCOPE_AGENT); }
__device__ __forceinline__ unsigned xb_xcc_id() { return (unsigned)__builtin_amdgcn_s_getreg((3 << 11) | 20) & 0xFu; }
#define XB_SPIN(cond, bar) do { unsigned _sp = 0; while (cond) { __builtin_amdgcn_s_sleep(1); \
    if ((++_sp & 255u) == 0u) { if (xb_ld(&(bar)[XB_TMO])) break; if (_sp > XB_SPIN_CAP) { atomicAdd(&(bar)[XB_TMO], 1u); break; } } } } while (0)
struct XcdBarrier { unsigned* bar; unsigned x; volatile LAS unsigned* st; };
__device__ __forceinline__ XcdBarrier xcd_barrier_post(unsigned* bar, volatile LAS unsigned* st) {
    XcdBarrier b; b.bar = bar; b.x = xb_xcc_id(); b.st = st;
    if (threadIdx.x == 0) (void)xb_add(&bar[XB_XCNT(b.x)], 1u);
    return b;
}
__device__ __forceinline__ void xcd_barrier_complete(unsigned* bar, unsigned x, unsigned& nloc, unsigned& nx) {
    const unsigned G = gridDim.x * gridDim.y * gridDim.z;
    unsigned sum, cnt, mine, sp = 0u;
    for (;;) {
        sum = 0u; cnt = 0u; mine = 0u;
#pragma unroll 1
        for (unsigned j = 0; j < 16; ++j) { const unsigned c = xb_ld(&bar[XB_XCNT(j)]); sum += c; cnt += (c > 0u) ? 1u : 0u; mine = (j == x) ? c : mine; }
        if (sum == G) break;
        __builtin_amdgcn_s_sleep(1);
        if ((++sp & 255u) == 0u) { if (xb_ld(&bar[XB_TMO])) break; if (sp > XB_SPIN_CAP) { atomicAdd(&bar[XB_TMO], 1u); break; } }
    }
    nloc = mine > 0u ? mine : 1u; nx = cnt > 0u ? cnt : 1u;
}
__device__ __forceinline__ void xcd_barrier(const XcdBarrier& b, unsigned* barw_in) {
    asm volatile("s_waitcnt vmcnt(0)" ::: "memory");
    __syncthreads();
    if (threadIdx.x == 0) {
        unsigned* bar = barw_in; asm volatile("" : "+s"(bar));
        __builtin_amdgcn_s_waitcnt(0);
        unsigned nloc = b.st[0], nx = b.st[1];
        if (nloc == 0u) { xcd_barrier_complete(bar, b.x, nloc, nx); b.st[0] = nloc; b.st[1] = nx; }
        const unsigned old = xb_add(&bar[XB_XSUB(b.x)], 1u);
        const unsigned gen = old / nloc;
        if (old + 1u == (gen + 1u) * nloc) {
            __builtin_amdgcn_fence(__ATOMIC_RELEASE, "agent");
            asm volatile("s_waitcnt vmcnt(0)" ::: "memory");
            const unsigned og = xb_add(&bar[XB_TOP], 1u);
            const unsigned tg = og / nx;
            if (og + 1u == (tg + 1u) * nx) xb_add(&bar[XB_TOPGEN], 1u);
            else XB_SPIN(xb_ld(&bar[XB_TOPGEN]) == tg, bar);
            __builtin_amdgcn_fence(__ATOMIC_ACQUIRE, "agent");
            xb_add(&bar[XB_XGEN(b.x)], 1u);
            asm volatile("s_waitcnt vmcnt(0)" ::: "memory");
        } else {
            XB_SPIN(xb_ld(&bar[XB_XGEN(b.x)]) == gen, bar);
            __builtin_amdgcn_fence(__ATOMIC_ACQUIRE, "agent");
            asm volatile("s_waitcnt vmcnt(0)" ::: "memory");
        }
    }
    __syncthreads();
}

struct Args {
    const float *x, *p, *g_mix, *w_in, *lb_logits, *g_hg, *conv_w, *w_gate, *b_gate, *g_gla, *w_out, *g_mlp, *w_up, *w_down, *g_ple, *w_pg, *w_pp, *g_final;
    float* out; unsigned char* ws; int ph_lo, ph_hi;
};
struct Frame {
    LAS unsigned char* lds;
    int tid, lane, wave, G, gw, NGW;
};
__device__ __forceinline__ float wave_sum(float v) {
    v += pg8::dpp_get<0xB1>(v); v += pg8::dpp_get<0x4E>(v); v += pg8::dpp_get<0x141>(v); v += pg8::dpp_get<0x140>(v);
    return pg8::sum_xor32(pg8::sum_xor16(v));
}
__device__ __forceinline__ float sigmoidf_(float x) { return __builtin_amdgcn_rcpf(1.0f + __builtin_amdgcn_exp2f(x * -1.4426950408889634f)); }
__device__ __forceinline__ float siluf_(float x) { return x * __builtin_amdgcn_rcpf(1.0f + __builtin_amdgcn_exp2f(x * -1.4426950408889634f)); }

template <bool F8 = false, bool TILED = true>
__device__ __forceinline__ void transpose_item(const float* W, int ldw, int k0, int n0, int ncols, bf16* WT, int K, int nrow0, const float* g, LAS float* scr, int lane) {
    const int r4 = lane >> 4, c4 = lane & 15;
    f32x4 v[16];
#pragma unroll
    for (int i = 0; i < 16; ++i) { const int row = 4 * i + r4; v[i] = (f32x4){0.f, 0.f, 0.f, 0.f}; if (c4 * 4 < ncols) v[i] = __builtin_nontemporal_load((const f32x4*)(W + (size_t)(k0 + row) * ldw + n0 + c4 * 4)); }
#pragma unroll
    for (int i = 0; i < 16; ++i) { const int row = 4 * i + r4; const float gs = (g ? g[k0 + row] : 1.0f) * (F8 ? pg8::F8_WSCALE : 1.0f);
        *(LAS f32x4*)(scr + row * 68 + ((c4 * 4) ^ ((row >> 3) << 2))) = v[i] * gs; }
    LDS_WAIT(); asm volatile("" ::: "memory");
    if constexpr (TILED) {
        const int r = lane >> 2, kp = lane & 3;
#pragma unroll
        for (int j = 0; j < 8; ++j) { const int blk = j >> 2, gq = (j >> 1) & 1, ksub = j & 1, k8 = ksub * 4 + kp, n = blk * 32 + pg8::perm32(16 * gq + r), q = nrow0 + blk * 32 + 16 * gq + r;
            const LAS float* s = scr + (8 * k8) * 68 + (n ^ (k8 << 2));
            if constexpr (F8) {
                v2u o8; o8.x = pg8::cvt_pk_fp8x4(s[0 * 68], s[1 * 68], s[2 * 68], s[3 * 68]); o8.y = pg8::cvt_pk_fp8x4(s[4 * 68], s[5 * 68], s[6 * 68], s[7 * 68]);
                *(GAS v2u*)((unsigned char*)WT + (((size_t)(q >> 4) * (K >> 6) + (k0 >> 6)) << 10) + (q & 15) * 64 + 8 * k8) = o8;
            } else {
                v4u o; o.x = pg8::cvt_pk_bf16(s[0 * 68], s[1 * 68]); o.y = pg8::cvt_pk_bf16(s[2 * 68], s[3 * 68]); o.z = pg8::cvt_pk_bf16(s[4 * 68], s[5 * 68]); o.w = pg8::cvt_pk_bf16(s[6 * 68], s[7 * 68]);
                *(GAS v4u*)(WT + (((size_t)(q >> 4) * (K >> 5) + (k0 >> 5) + ksub) << 9) + (q & 15) * 32 + 8 * kp) = o; } }
    } else {
    const int c = lane & 7;
    #pragma unroll
        for (int j = 0; j < 8; ++j) { const int n = (lane >> 3) + 8 * j; const LAS float* s = scr + (8 * c) * 68 + (n ^ (c << 2));
            if constexpr (F8) {
                v2u o8; o8.x = pg8::cvt_pk_fp8x4(s[0 * 68], s[1 * 68], s[2 * 68], s[3 * 68]); o8.y = pg8::cvt_pk_fp8x4(s[4 * 68], s[5 * 68], s[6 * 68], s[7 * 68]);
                if (n < ncols) *(GAS v2u*)((unsigned char*)WT + (size_t)(nrow0 + n) * K + k0 + 8 * c) = o8; continue; }
            v4u o; o.x = pg8::cvt_pk_bf16(s[0 * 68], s[1 * 68]); o.y = pg8::cvt_pk_bf16(s[2 * 68], s[3 * 68]); o.z = pg8::cvt_pk_bf16(s[4 * 68], s[5 * 68]); o.w = pg8::cvt_pk_bf16(s[6 * 68], s[7 * 68]);
            if (n < ncols) *(GAS v4u*)(WT + (size_t)(nrow0 + n) * K + k0 + 8 * c) = o; }
}
    LDS_WAIT(); asm volatile("" ::: "memory");
}

__device__ __forceinline__ void prologue(const Args& a, Frame& F) {
    LAS float* scr = (LAS float*)(F.lds + RING_OFF + F.wave * 17408);
    constexpr int I_IN = 32 * 112, I_GA = 32, I_OUT = 32 * 32, I_UP = 32 * 128, I_DN = 128 * 32, I_PG = 32 * 32, I_PP = 4 * 32;
    constexpr int I_LAYER = I_IN + I_GA + I_OUT + I_UP + I_DN + I_PG + I_PP;
    for (int it = F.gw; it < DEPTH * I_LAYER; it += F.NGW) {
        const int l = it / I_LAYER; int r = it % I_LAYER;
        unsigned char* wl = a.ws + WS_W + (size_t)l * W_LAYER;
        if (r < I_IN) { const int kb = r / 112, nb = r % 112; transpose_item(a.w_in + (size_t)l * D * INW, INW, 64 * kb, 64 * nb, 64, (bf16*)(wl + WO_IN), D, 64 * nb, a.g_mix + l * D, scr, F.lane); continue; } r -= I_IN;
        if (r < I_GA) { transpose_item<false, false>(a.w_in + (size_t)l * D * INW, INW, 64 * r, ZW, 16, (bf16*)(wl + WO_GA), D, 0, a.g_mix + l * D, scr, F.lane); continue; } r -= I_GA;
        if (r < I_OUT) { const int kb = r / 32, nb = r % 32; transpose_item(a.w_out + (size_t)l * D * D, D, 64 * kb, 64 * nb, 64, (bf16*)(wl + WO_OUT), D, 64 * nb, nullptr, scr, F.lane); continue; } r -= I_OUT;
        if (r < I_UP) { const int kb = r / 128, nb = r % 128; transpose_item(a.w_up + (size_t)l * D * FF, FF, 64 * kb, 64 * nb, 64, (bf16*)(wl + WO_UP), D, 64 * nb, a.g_mlp + l * D, scr, F.lane); continue; } r -= I_UP;
        if (r < I_DN) { const int kb = r / 32, nb = r % 32; transpose_item(a.w_down + (size_t)l * FF * D, D, 64 * kb, 64 * nb, 64, (bf16*)(wl + WO_DN), FF, 64 * nb, nullptr, scr, F.lane); continue; } r -= I_DN;
        if (r < I_PG) { const int kb = r / 32, nb = r % 32; transpose_item<true>(a.w_pg + (size_t)l * D * D, D, 64 * kb, 64 * nb, 64, (bf16*)(wl + WO_PG), D, 64 * nb, a.g_ple + l * D, scr, F.lane); continue; } r -= I_PG;
        { const int kb = r / 32, nb = r % 32; transpose_item(a.w_pp + (size_t)l * PLE * D, D, 64 * kb, 64 * nb, 64, (bf16*)(wl + WO_PP), PLE, 64 * nb, nullptr, scr, F.lane); }
    }
    bf16* hb = (bf16*)(a.ws + WS_HBA); float* st = (float*)(a.ws + WS_STATS);
    for (int m0 = F.gw; m0 < M; m0 += 2 * F.NGW) {
        f32x4 v[2][8];
#pragma unroll
        for (int r = 0; r < 2; ++r) { const int m = m0 + r * F.NGW; if (m < M) { const GAS f32x4* xr = (const GAS f32x4*)(a.x + (size_t)m * D) + F.lane;
#pragma unroll
            for (int j = 0; j < 8; ++j) v[r][j] = xr[64 * j]; } }
#pragma unroll
        for (int r = 0; r < 2; ++r) { const int m = m0 + r * F.NGW; if (m < M) { float s = 0.f;
#pragma unroll
            for (int j = 0; j < 8; ++j) { const f32x4 q = v[r][j]; s += (q.x * q.x + q.y * q.y) + (q.z * q.z + q.w * q.w); v2u w; w.x = pg8::cvt_pk_bf16(q.x, q.y); w.y = pg8::cvt_pk_bf16(q.z, q.w); *(GAS v2u*)(hb + pg8::tile_rc(m, 4 * (F.lane + 64 * j), D)) = w; }
            s = wave_sum(s);
            if (F.lane < 32) st[(size_t)m * 32 + F.lane] = (F.lane == 0) ? s : 0.f; } }
    }
}

__device__ __forceinline__ void ga_phase(const Args& a, Frame& F, const bf16* hb, const bf16* wga, const float* stats, float* GA) {
    typedef short bf16x8g __attribute__((ext_vector_type(8)));
    const int fr = F.lane & 15, fq = F.lane >> 4, tl = F.wave & 3, kh = F.wave >> 2;
    LAS f32x4* part = (LAS f32x4*)(F.lds);
    for (int t = blockIdx.x * 4 + tl; t < M / 16; t += F.G * 4) {
        const int row0 = t * 16;
        const bf16* ap = hb + pg8::tile_rc(row0 + fr, kh * (D / 2) + fq * 8, D);
        const bf16* bp = wga + (size_t)fr * D + kh * (D / 2) + fq * 8;
        f32x4 acc = {0.f, 0.f, 0.f, 0.f};
#pragma unroll 8
        for (int kk = 0; kk < D / 64; ++kk) {
            const bf16x8g av = *(const bf16x8g*)(ap + kk * 512), bv = *(const bf16x8g*)(bp + kk * 32);
            acc = __builtin_amdgcn_mfma_f32_16x16x32_bf16(av, bv, acc, 0, 0, 0); }
        if (kh == 1) part[tl * 64 + F.lane] = acc;
        __syncthreads();
        if (kh == 0) {
            acc = acc + part[tl * 64 + F.lane];
            const f32x4* sp = (const f32x4*)(stats + (size_t)(row0 + fr) * 32 + fq * 8); const f32x4 s0 = sp[0], s1 = sp[1];
            float sv = ((s0[0] + s0[1]) + (s0[2] + s0[3])) + ((s1[0] + s1[1]) + (s1[2] + s1[3]));
            sv = pg8::sum_xor16(sv); sv = pg8::sum_xor32(sv);
            const float rstd = __builtin_amdgcn_rsqf(sv * (1.0f / D) + EPS);
#pragma unroll
            for (int i = 0; i < 4; ++i) GA[(size_t)(row0 + 4 * fq + i) * GRANK + fr] = acc[i] * __builtin_bit_cast(float, __builtin_amdgcn_ds_bpermute((4 * fq + i) * 4, __builtin_bit_cast(int, rstd)));
        }
        __syncthreads();
    }
}

__device__ __forceinline__ void pb_phase(const Args& a, Frame& F, int l) {
    const GAS f32x4* src = (const GAS f32x4*)(a.p + (size_t)l * M * PLE); GAS v2u* dst = (GAS v2u*)(a.ws + WS_PB);
    const size_t n4 = (size_t)M * PLE / 4;
    const size_t stride = (size_t)F.G * 512;
    for (size_t i0 = (size_t)blockIdx.x * 512 + F.tid; i0 < n4; i0 += 8 * stride) {
        f32x4 v[8];
#pragma unroll
        for (int j = 0; j < 8; ++j) { const size_t i = i0 + j * stride; v[j] = (i < n4) ? src[i] : (f32x4){0.f, 0.f, 0.f, 0.f}; }
#pragma unroll
        for (int j = 0; j < 8; ++j) { const size_t i = i0 + j * stride; if (i < n4) { v2u w; w.x = pg8::cvt_pk_bf16(v[j].x, v[j].y); w.y = pg8::cvt_pk_bf16(v[j].z, v[j].w); dst[i] = w; } }
    }
}

namespace mx {
typedef short bf16x8 __attribute__((ext_vector_type(8)));
typedef float f32x2v __attribute__((ext_vector_type(2)));
constexpr int AR = 0;
constexpr int RS128 = 272, RS256 = 528, TS = 144;
constexpr int RW128 = 256, RW256 = 512;
constexpr int A_RAWQ = 0, A_RAWK = 17408, A_RAWV = 34816;
constexpr int A_GAT = 69632;
constexpr int A_QT = 73728, A_KT = 91136, A_KDT = A_QT, A_VT = 108544, A_P = 145408;
constexpr int A_TOT = 154624, A_RED = 156672, A_DV = 158720, A_EMV = 159232, A_END = 159744;
constexpr int A_YST = A_QT;
static_assert(AR + A_END <= LDSCTL_OFF, "mixer arena vs LDS control words");
constexpr int E_TOTAL = 8 * 128 * 128 + 4 * 256 * 128;
constexpr int SUPER = 4, NSUPER = NCHUNK / SUPER;
constexpr float XCL = 100.0f;

template <int DV> __device__ __forceinline__ size_t st_off(int v, int k4, int fq) { return ((size_t)((2 * k4 + (fq >> 1)) * DV + v) << 4) + 8 * (fq & 1); }
__device__ __forceinline__ float clampx(float x) { return fminf(fmaxf(x, -XCL), XCL); }
__device__ __forceinline__ void wg_sync() { asm volatile("s_waitcnt vmcnt(0) lgkmcnt(0)" ::: "memory"); __builtin_amdgcn_s_barrier(); asm volatile("" ::: "memory"); }
__device__ __forceinline__ void wg_sync_lds() { asm volatile("s_waitcnt lgkmcnt(0)" ::: "memory"); __builtin_amdgcn_s_barrier(); asm volatile("" ::: "memory"); }
__device__ __forceinline__ unsigned pk(float lo, float hi) { return pg8::cvt_pk_bf16(lo, hi); }

template <bool GLA, bool M3>
__device__ __forceinline__ void raw_issue(LAS unsigned char* ar, const int wave, const int lane, const bf16* Z, const float* GAg, const unsigned char* zero_page, const int t0, const int hu, const int buf) {
    const int oK = (!GLA && !M3 && buf) ? A_RAWQ : A_RAWK, oV = A_RAWV + ((!GLA && !M3 && buf) ? 17408 : 0);
#define MX_DMA(src, dstoff) __builtin_amdgcn_global_load_lds((const unsigned*)(src), (LAS unsigned*)(ar + (dstoff)), 16, 0, 0)
    if (!GLA) {
#pragma unroll
        for (int i = 0; i < 2; ++i) { const int pi = wave + 8 * i, row = 4 * pi + (lane >> 4), pc = lane & 15;
            const bf16* src = Z + pg8::tile_rc(t0 + row, hu * 128 + pc * 8, ZW);
            if (M3) MX_DMA(src + ZC_HQ * 16, A_RAWQ + pi * 1024);
            MX_DMA(src + ZC_HF * 16, oK + pi * 1024);
            MX_DMA(src + ZC_HI * 16, oV + pi * 1024); }
    } else {
#pragma unroll
        for (int i = 0; i < 3; ++i) { const int pi = wave + 8 * i;
            if (pi < 17) { int row = 4 * pi + (lane >> 4); row = row < 67 ? row : 66; const int pc = lane & 15, t = t0 - 3 + row;
                const unsigned char* base = (t < 0) ? (zero_page + pc * 16) : (const unsigned char*)(Z + pg8::tile_rc(t < 0 ? 0 : t, hu * 128 + pc * 8, ZW));
                const unsigned char* sq = (t < 0) ? base : base + ZC_GQ * 32; const unsigned char* sk = (t < 0) ? base : base + ZC_GK * 32;
                if (M3) MX_DMA(sq, A_RAWQ + pi * 1024);
                MX_DMA(sk, A_RAWK + pi * 1024); } }
#pragma unroll
        for (int i = 0; i < 5; ++i) { const int pi = wave + 8 * i;
            if (pi < 34) { int row = 2 * pi + (lane >> 5); row = row < 67 ? row : 66; const int pc = lane & 31, t = t0 - 3 + row;
                const unsigned char* sv = (t < 0) ? (zero_page + pc * 16) : (const unsigned char*)(Z + pg8::tile_rc(t < 0 ? 0 : t, ZC_GV + hu * 256 + pc * 8, ZW));
                MX_DMA(sv, A_RAWV + pi * 1024); } }
        if (wave < 4) MX_DMA(GAg + (size_t)t0 * GRANK + wave * 256 + lane * 4, A_GAT + wave * 1024);
    }
#undef MX_DMA
}

template <bool GLA, bool M3> struct Carry {
    static constexpr int DV = GLA ? 256 : 128, NVT = DV / 128;
    f32x4 acc[M3 ? 1 : DV / 16];
    v4u S[M3 ? NVT : 1][4];
    float dsum, lb;
};

template <bool GLA, bool M3>
__device__ __forceinline__ void mix_step(const Args& a, LAS unsigned char* ar, const int wave, const int lane, const int l, const int chunk, const int hu, const int j4,
                                         const bool has_next, const int nchunk, const int nhu,
                                         const bf16* Z, const float* GAg, const unsigned char* zero_page, bf16* SB, bf16* SSUP, float* DSUP, bf16* Y, Carry<GLA, M3>& C) {
    const int tid = wave * 64 + lane, t0 = chunk * CHUNK;
    constexpr int DV = GLA ? 256 : 128, NVT = DV / 128;
    const int c = tid & 127, seg = tid >> 7;
    const int fr = lane & 15, fq = lane >> 4;
    const int chq = GLA ? (1024 + hu * 128) : (hu * 128);
    const size_t eoff = GLA ? (131072 + hu * 32768) : (hu * 16384);
    const size_t sbase = (size_t)chunk * E_TOTAL + eoff, supbase = (size_t)(chunk / SUPER) * E_TOTAL + eoff;
    float ck0 = 0.f, ck1 = 0.f, ck2 = 0.f, ck3 = 0.f, cq0 = 0.f, cq1 = 0.f, cq2 = 0.f, cq3 = 0.f, bgv = 0.f;
    float wgf[8];
    if (GLA) {
        const float* cwk = a.conv_w + (size_t)l * 4 * CONVC + 512 + hu * 128 + c; ck0 = cwk[0]; ck1 = cwk[CONVC]; ck2 = cwk[2 * CONVC]; ck3 = cwk[3 * CONVC];
        if (M3) { const float* cwq = a.conv_w + (size_t)l * 4 * CONVC + hu * 128 + c; cq0 = cwq[0]; cq1 = cwq[CONVC]; cq2 = cwq[2 * CONVC]; cq3 = cwq[3 * CONVC]; }
        bgv = a.b_gate[(size_t)l * GKW + hu * 128 + c];
        const float* wgp = a.w_gate + (size_t)l * GRANK * GKW + (size_t)((fq & 1) * 8) * GKW + hu * 128 + wave * 16 + fr;
#pragma unroll
        for (int r = 0; r < 8; ++r) wgf[r] = (fq < 2) ? wgp[r * GKW] : 0.f;
    }
    wg_sync();
    constexpr bool DBUF = !GLA && !M3;
    const int oK = (DBUF && (j4 & 1)) ? A_RAWQ : A_RAWK, oV = A_RAWV + ((DBUF && (j4 & 1)) ? 17408 : 0);
    if (DBUF && has_next) raw_issue<GLA, M3>(ar, wave, lane, Z, GAg, zero_page, nchunk * CHUNK, nhu, (j4 + 1) & 1);
    constexpr int XGP = 132;
    if (GLA) {
        const bf16x8 bw = __builtin_bit_cast(bf16x8, (v4u){pk(wgf[0], wgf[1]), pk(wgf[2], wgf[3]), pk(wgf[4], wgf[5]), pk(wgf[6], wgf[7])});
#pragma unroll
        for (int tt = 0; tt < 4; ++tt) {
            const LAS f32x4* gp = (const LAS f32x4*)(ar + A_GAT + (tt * 16 + fr) * 64 + (fq & 1) * 32); const f32x4 g0 = gp[0], g1 = gp[1];
            const v4u aw = {pk(g0[0], g0[1]), pk(g0[2], g0[3]), pk(g1[0], g1[1]), pk(g1[2], g1[3])};
            const bf16x8 ag = __builtin_bit_cast(bf16x8, (fq < 2) ? aw : (v4u){0u, 0u, 0u, 0u});
            f32x4 xa = {0.f, 0.f, 0.f, 0.f};
            xa = __builtin_amdgcn_mfma_f32_16x16x32_bf16(ag, bw, xa, 0, 0, 0);
#pragma unroll
            for (int i = 0; i < 4; ++i) ((LAS float*)(ar + A_QT))[(tt * 16 + 4 * fq + i) * XGP + wave * 16 + fr] = xa[i]; }
        wg_sync_lds();
    }
    constexpr bool HOIST = M3 && !GLA;
    v4u dsl[M3 ? NVT : 1][4]; v2u gate[M3 ? NVT : 1][4];
    const bf16* dsrc = (j4 < SUPER - 1) ? (SB + sbase) : (const bf16*)zero_page;
    const int gcol0 = GLA ? (ZC_GR + hu * 256) : (ZC_HG + hu * 128);
    if (HOIST) {
#pragma unroll
        for (int jv = 0; jv < NVT; ++jv) {
#pragma unroll
            for (int k4 = 0; k4 < 4; ++k4) dsl[jv][k4] = *(const v4u*)(dsrc + st_off<DV>((wave + 8 * jv) * 16 + fr, k4, fq));
#pragma unroll
            for (int tt = 0; tt < 4; ++tt) gate[jv][tt] = *(const v2u*)(Z + pg8::tile_rc(t0 + tt * 16 + fr, gcol0 + (wave + 8 * jv) * 16 + 4 * fq, ZW)); }
    }
    {
        const int sg = tid >> 7;
#pragma unroll
        for (int j = 0; j < NVT; ++j) { const int v = (tid & 127) + 128 * j; unsigned w[8];
            if (!GLA) {
#pragma unroll
                for (int i = 0; i < 8; ++i) { const unsigned lo = *(const LAS bf16*)(ar + oV + (sg * 16 + 2 * i) * RW128 + v * 2), hi = *(const LAS bf16*)(ar + oV + (sg * 16 + 2 * i + 1) * RW128 + v * 2); w[i] = lo | (hi << 16); }
            } else {
                const float* cw = a.conv_w + (size_t)l * 4 * CONVC + 1024 + hu * 256 + v; const float w0 = cw[0], w1 = cw[CONVC], w2 = cw[2 * CONVC], w3 = cw[3 * CONVC];
                float x0 = bf2f(*(const LAS bf16*)(ar + A_RAWV + (sg * 16 + 0) * RW256 + v * 2)), x1 = bf2f(*(const LAS bf16*)(ar + A_RAWV + (sg * 16 + 1) * RW256 + v * 2)), x2 = bf2f(*(const LAS bf16*)(ar + A_RAWV + (sg * 16 + 2) * RW256 + v * 2));
                float o[16];
#pragma unroll
                for (int i = 0; i < 16; ++i) { const float x3 = bf2f(*(const LAS bf16*)(ar + A_RAWV + (sg * 16 + i + 3) * RW256 + v * 2)); o[i] = siluf_(w0 * x0 + w1 * x1 + w2 * x2 + w3 * x3); x0 = x1; x1 = x2; x2 = x3; }
#pragma unroll
                for (int i = 0; i < 8; ++i) w[i] = pk(o[2 * i], o[2 * i + 1]);
            }
            v4u wa = {w[0], w[1], w[2], w[3]}, wb = {w[4], w[5], w[6], w[7]};
            *(LAS v4u*)(ar + A_VT + v * TS + sg * 32) = wa; *(LAS v4u*)(ar + A_VT + v * TS + sg * 32 + 16) = wb; }
    }
    {
        float lf[16], kk[16], qq[16];
        if (!GLA) {
            const float lb = C.lb;
#pragma unroll
            for (int i = 0; i < 16; ++i) { const int lt = seg * 16 + i; const float zf = bf2f(*(const LAS bf16*)(ar + oK + lt * RW128 + c * 2));
                const float en = __builtin_amdgcn_exp2f(zf * -1.4426950408889634f), sg = __builtin_amdgcn_rcpf(1.0f + en), f = lb + (1.0f - lb) * sg;
                lf[i] = __builtin_amdgcn_logf(f); kk[i] = (1.0f - lb) * (en * sg);
                if (M3) qq[i] = bf2f(*(const LAS bf16*)(ar + A_RAWQ + lt * RW128 + c * 2)); }
        } else {
            float xk0 = bf2f(*(const LAS bf16*)(ar + A_RAWK + (seg * 16 + 0) * RW128 + c * 2)), xk1 = bf2f(*(const LAS bf16*)(ar + A_RAWK + (seg * 16 + 1) * RW128 + c * 2)), xk2 = bf2f(*(const LAS bf16*)(ar + A_RAWK + (seg * 16 + 2) * RW128 + c * 2));
            float xq0 = 0.f, xq1 = 0.f, xq2 = 0.f;
            if (M3) { xq0 = bf2f(*(const LAS bf16*)(ar + A_RAWQ + (seg * 16 + 0) * RW128 + c * 2)); xq1 = bf2f(*(const LAS bf16*)(ar + A_RAWQ + (seg * 16 + 1) * RW128 + c * 2)); xq2 = bf2f(*(const LAS bf16*)(ar + A_RAWQ + (seg * 16 + 2) * RW128 + c * 2)); }
#pragma unroll
            for (int i = 0; i < 16; ++i) { const int lt = seg * 16 + i;
                const float xk3 = bf2f(*(const LAS bf16*)(ar + A_RAWK + (lt + 3) * RW128 + c * 2)); kk[i] = siluf_(ck0 * xk0 + ck1 * xk1 + ck2 * xk2 + ck3 * xk3); xk0 = xk1; xk1 = xk2; xk2 = xk3;
                if (M3) { const float xq3 = bf2f(*(const LAS bf16*)(ar + A_RAWQ + (lt + 3) * RW128 + c * 2)); qq[i] = siluf_(cq0 * xq0 + cq1 * xq1 + cq2 * xq2 + cq3 * xq3) * 0.08838834764831845f; xq0 = xq1; xq1 = xq2; xq2 = xq3; }
                const float xg = bgv + ((const LAS float*)(ar + A_QT))[lt * XGP + c];
                lf[i] = (fminf(xg, 0.f) * 1.4426950408889634f - __builtin_amdgcn_logf(1.0f + __builtin_amdgcn_exp2f(fabsf(xg) * -1.4426950408889634f))) * (1.0f / 16.0f); }
        }
#pragma unroll
        for (int i = 1; i < 16; ++i) lf[i] += lf[i - 1];
        ((LAS float*)(ar + A_TOT))[seg * 128 + c] = lf[15];
        wg_sync_lds();
        if (!DBUF && has_next) raw_issue<GLA, M3>(ar, wave, lane, Z, GAg, zero_page, nchunk * CHUNK, nhu, 0);
        const float t0s = ((const LAS float*)(ar + A_TOT))[c], t1s = ((const LAS float*)(ar + A_TOT))[128 + c], t2s = ((const LAS float*)(ar + A_TOT))[256 + c], t3s = ((const LAS float*)(ar + A_TOT))[384 + c];
        const float mref = t0s + t1s, blast = (t0s + t1s) + (t2s + t3s);
        const float off = (seg == 0) ? 0.f : (seg == 1) ? t0s : (seg == 2) ? (t0s + t1s) : ((t0s + t1s) + t2s);
        if (seg == 0) { ((LAS float*)(ar + A_DV))[c] = __builtin_amdgcn_exp2f(blast); if (M3) ((LAS float*)(ar + A_EMV))[c] = __builtin_amdgcn_exp2f(mref); }
        if (M3) {
#pragma unroll
            for (int i = 0; i < 16; ++i) { const int lt = seg * 16 + i; const float b = off + lf[i];
                const unsigned qk = pk(qq[i] * __builtin_amdgcn_exp2f(fminf(b - mref, XCL)), kk[i] * __builtin_amdgcn_exp2f(fminf(mref - b, XCL)));
                *(LAS bf16*)(ar + A_QT + lt * RS128 + c * 2) = (bf16)(qk & 0xffffu);
                *(LAS bf16*)(ar + A_KT + lt * RS128 + c * 2) = (bf16)(qk >> 16); }
        } else {
            unsigned w[8];
#pragma unroll
            for (int i = 0; i < 8; ++i) { const float b0 = off + lf[2 * i], b1 = off + lf[2 * i + 1]; w[i] = pk(kk[2 * i] * __builtin_amdgcn_exp2f(blast - b0), kk[2 * i + 1] * __builtin_amdgcn_exp2f(blast - b1)); }
            v4u wa = {w[0], w[1], w[2], w[3]}, wb = {w[4], w[5], w[6], w[7]};
            *(LAS v4u*)(ar + A_KDT + c * TS + seg * 32) = wa; *(LAS v4u*)(ar + A_KDT + c * TS + seg * 32 + 16) = wb;
            if (seg == 0) { C.dsum += blast; if (j4 == SUPER - 1) DSUP[(size_t)(chunk / SUPER) * 1536 + chq + c] = __builtin_amdgcn_exp2f(C.dsum); }
        }
    }
    wg_sync_lds();
    if (!M3) {
        const bf16x8 a0 = *(const LAS bf16x8*)(ar + A_KDT + (wave * 16 + fr) * TS + fq * 16), a1 = *(const LAS bf16x8*)(ar + A_KDT + (wave * 16 + fr) * TS + fq * 16 + 64);
        const f32x4 dv = *(const LAS f32x4*)(ar + A_DV + (wave * 16 + 4 * fq) * 4);
        const size_t orow = ((size_t)(wave * DV + (fq & 1) * 16 + fr) << 4) + 4 * (fq & ~1);
#pragma unroll
        for (int vt = 0; vt < DV / 16; vt += 2) {
            f32x4 t2[2];
#pragma unroll
            for (int h = 0; h < 2; ++h) {
                const bf16x8 b0 = *(const LAS bf16x8*)(ar + A_VT + ((vt + h) * 16 + fr) * TS + fq * 16), b1 = *(const LAS bf16x8*)(ar + A_VT + ((vt + h) * 16 + fr) * TS + fq * 16 + 64);
                f32x4 t = {0.f, 0.f, 0.f, 0.f};
                t = __builtin_amdgcn_mfma_f32_16x16x32_bf16(a0, b0, t, 0, 0, 0);
                t = __builtin_amdgcn_mfma_f32_16x16x32_bf16(a1, b1, t, 0, 0, 0);
                t2[h] = t; }
            if (j4 < SUPER - 1) {
                const auto r0 = __builtin_amdgcn_permlane16_swap(pk(t2[0][0], t2[0][1]), pk(t2[1][0], t2[1][1]), false, false);
                const auto r1 = __builtin_amdgcn_permlane16_swap(pk(t2[0][2], t2[0][3]), pk(t2[1][2], t2[1][3]), false, false);
                v4u o; o.x = (unsigned)r0[0]; o.y = (unsigned)r1[0]; o.z = (unsigned)r0[1]; o.w = (unsigned)r1[1];
                *(v4u*)(SB + sbase + (size_t)vt * 16 * 16 + orow) = o; }
            C.acc[vt] = C.acc[vt] * dv + t2[0]; C.acc[vt + 1] = C.acc[vt + 1] * dv + t2[1];
            if (j4 == SUPER - 1) {
                const auto r0 = __builtin_amdgcn_permlane16_swap(pk(C.acc[vt][0], C.acc[vt][1]), pk(C.acc[vt + 1][0], C.acc[vt + 1][1]), false, false);
                const auto r1 = __builtin_amdgcn_permlane16_swap(pk(C.acc[vt][2], C.acc[vt][3]), pk(C.acc[vt + 1][2], C.acc[vt + 1][3]), false, false);
                v4u o; o.x = (unsigned)r0[0]; o.y = (unsigned)r1[0]; o.z = (unsigned)r0[1]; o.w = (unsigned)r1[1];
                *(v4u*)(SSUP + supbase + (size_t)vt * 16 * 16 + orow) = o; } }
    } else {
        {
            const int tt = wave & 3;
#pragma unroll
            for (int j = 0; j < 2; ++j) { const int st = (wave >> 2) * 2 + j;
                f32x4 acc = {0.f, 0.f, 0.f, 0.f};
#pragma unroll
                for (int k4 = 0; k4 < 4; ++k4) { const bf16x8 ak = *(const LAS bf16x8*)(ar + A_KT + (st * 16 + fr) * RS128 + fq * 16 + k4 * 64), bq = *(const LAS bf16x8*)(ar + A_QT + (tt * 16 + fr) * RS128 + fq * 16 + k4 * 64);
                    acc = __builtin_amdgcn_mfma_f32_16x16x32_bf16(ak, bq, acc, 0, 0, 0); }
#pragma unroll
                for (int i = 0; i < 4; ++i) acc[i] = (st * 16 + 4 * fq + i <= tt * 16 + fr) ? acc[i] : 0.f;
                v2u o; o.x = pk(acc[0], acc[1]); o.y = pk(acc[2], acc[3]);
                *(LAS v2u*)(ar + A_P + (tt * 16 + fr) * TS + (st * 16 + 4 * fq) * 2) = o; }
        }
        if (!HOIST) {
#pragma unroll
            for (int jv = 0; jv < NVT; ++jv)
#pragma unroll
                for (int tt = 0; tt < 4; ++tt) gate[jv][tt] = *(const v2u*)(Z + pg8::tile_rc(t0 + tt * 16 + fr, gcol0 + (wave + 8 * jv) * 16 + 4 * fq, ZW));
        }
        wg_sync_lds();
        f32x4 oacc[NVT][4];
#pragma unroll
        for (int jv = 0; jv < NVT; ++jv) { const int vt = wave + 8 * jv;
            const bf16x8 va0 = *(const LAS bf16x8*)(ar + A_VT + (vt * 16 + fr) * TS + fq * 16), va1 = *(const LAS bf16x8*)(ar + A_VT + (vt * 16 + fr) * TS + fq * 16 + 64);
            bf16x8 sa[4];
            if (!HOIST) {
#pragma unroll
                for (int k4 = 0; k4 < 4; ++k4) dsl[jv][k4] = *(const v4u*)(dsrc + st_off<DV>(vt * 16 + fr, k4, fq));
            }
#pragma unroll
            for (int k4 = 0; k4 < 4; ++k4) { const f32x4 e0 = *(const LAS f32x4*)(ar + A_EMV + (k4 * 32 + fq * 8) * 4), e1 = *(const LAS f32x4*)(ar + A_EMV + (k4 * 32 + fq * 8 + 4) * 4);
                const v4u sp = C.S[jv][k4]; v4u w;
                w.x = pk(pg8::bf_lo(sp.x) * e0[0], pg8::bf_hi(sp.x) * e0[1]); w.y = pk(pg8::bf_lo(sp.y) * e0[2], pg8::bf_hi(sp.y) * e0[3]);
                w.z = pk(pg8::bf_lo(sp.z) * e1[0], pg8::bf_hi(sp.z) * e1[1]); w.w = pk(pg8::bf_lo(sp.w) * e1[2], pg8::bf_hi(sp.w) * e1[3]);
                sa[k4] = __builtin_bit_cast(bf16x8, w); }
#pragma unroll
            for (int tt = 0; tt < 4; ++tt) { f32x4 acc = {0.f, 0.f, 0.f, 0.f};
                const bf16x8 p0 = *(const LAS bf16x8*)(ar + A_P + (tt * 16 + fr) * TS + fq * 16);
                acc = __builtin_amdgcn_mfma_f32_16x16x32_bf16(va0, p0, acc, 0, 0, 0);
                if (tt >= 2) { const bf16x8 p1 = *(const LAS bf16x8*)(ar + A_P + (tt * 16 + fr) * TS + fq * 16 + 64); acc = __builtin_amdgcn_mfma_f32_16x16x32_bf16(va1, p1, acc, 0, 0, 0); }
#pragma unroll
                for (int k4 = 0; k4 < 4; ++k4) { const bf16x8 bq = *(const LAS bf16x8*)(ar + A_QT + (tt * 16 + fr) * RS128 + fq * 16 + k4 * 64); acc = __builtin_amdgcn_mfma_f32_16x16x32_bf16(sa[k4], bq, acc, 0, 0, 0); }
                oacc[jv][tt] = acc; }
            {
#pragma unroll
                for (int k4 = 0; k4 < 4; ++k4) { const f32x4 d0 = *(const LAS f32x4*)(ar + A_DV + (k4 * 32 + fq * 8) * 4), d1 = *(const LAS f32x4*)(ar + A_DV + (k4 * 32 + fq * 8 + 4) * 4);
                    const v4u sp = C.S[jv][k4], dl = dsl[jv][k4]; v4u w;
                    w.x = pk(pg8::bf_lo(sp.x) * d0[0] + pg8::bf_lo(dl.x), pg8::bf_hi(sp.x) * d0[1] + pg8::bf_hi(dl.x)); w.y = pk(pg8::bf_lo(sp.y) * d0[2] + pg8::bf_lo(dl.y), pg8::bf_hi(sp.y) * d0[3] + pg8::bf_hi(dl.y));
                    w.z = pk(pg8::bf_lo(sp.z) * d1[0] + pg8::bf_lo(dl.z), pg8::bf_hi(sp.z) * d1[1] + pg8::bf_hi(dl.z)); w.w = pk(pg8::bf_lo(sp.w) * d1[2] + pg8::bf_lo(dl.w), pg8::bf_hi(sp.w) * d1[3] + pg8::bf_hi(dl.w));
                    C.S[jv][k4] = w; }
            }
        }
#pragma unroll
        for (int tt = 0; tt < 4; ++tt) { float ss = 0.f;
#pragma unroll
            for (int jv = 0; jv < NVT; ++jv) ss += (oacc[jv][tt][0] * oacc[jv][tt][0] + oacc[jv][tt][1] * oacc[jv][tt][1]) + (oacc[jv][tt][2] * oacc[jv][tt][2] + oacc[jv][tt][3] * oacc[jv][tt][3]);
            ss = pg8::sum_xor16(ss); ss = pg8::sum_xor32(ss);
            if (fq == 0) ((LAS float*)(ar + A_RED))[(tt * 16 + fr) * 8 + wave] = ss; }
        wg_sync_lds();
        const float* gn = GLA ? (a.g_gla + (size_t)l * GLAW + hu * 256) : (a.g_hg + (size_t)l * HGW + hu * 128);
#pragma unroll
        for (int tt = 0; tt < 4; ++tt) { const int t = tt * 16 + fr;
            const f32x4 r0 = *(const LAS f32x4*)(ar + A_RED + t * 32), r1 = *(const LAS f32x4*)(ar + A_RED + t * 32 + 16);
            const float ms = (((r0[0] + r0[1]) + (r0[2] + r0[3])) + ((r1[0] + r1[1]) + (r1[2] + r1[3]))) * (1.0f / DV);
            const float rstd = __builtin_amdgcn_rsqf(ms + EPS);
#pragma unroll
            for (int jv = 0; jv < NVT; ++jv) { const int v = (wave + 8 * jv) * 16 + 4 * fq;
                const f32x4 g4 = *(const f32x4*)(gn + v); const v2u gw = gate[jv][tt];
                const float y0 = oacc[jv][tt][0] * rstd * g4[0] * siluf_(pg8::bf_lo(gw.x)), y1 = oacc[jv][tt][1] * rstd * g4[1] * siluf_(pg8::bf_hi(gw.x));
                const float y2 = oacc[jv][tt][2] * rstd * g4[2] * siluf_(pg8::bf_lo(gw.y)), y3 = oacc[jv][tt][3] * rstd * g4[3] * siluf_(pg8::bf_hi(gw.y));
                v2u o; o.x = pk(y0, y1); o.y = pk(y2, y3);
                *(LAS v2u*)(ar + A_YST + t * (GLA ? RS256 : RS128) + v * 2) = o; } }
        wg_sync_lds();
        {
            constexpr int PPR = DV / 8;
            const int ycol0 = GLA ? (1024 + hu * 256) : (hu * 128);
#pragma unroll
            for (int i = 0; i < (64 * PPR) / 512; ++i) { const int sidx = wave + 8 * i, rg = sidx / (DV / 32), scol = sidx % (DV / 32), r = rg * 16 + (lane >> 2), cc = scol * 32 + (lane & 3) * 8;
                *(v4u*)(Y + pg8::tile_rc(t0 + r, ycol0 + cc, 2048)) = *(const LAS v4u*)(ar + A_YST + r * (GLA ? RS256 : RS128) + cc * 2); }
        }
    }
}

template <bool GLA, bool M3>
__device__ __forceinline__ void mix_head(const Args& a, LAS unsigned char* ar, const int wave, const int l, const int sc, const int hu, const bf16* Z, const float* GAg, const unsigned char* zero_page, bf16* SB, bf16* SSUP, float* DSUP, bf16* Y) {
    constexpr int DV = GLA ? 256 : 128, NVT = DV / 128;
    Carry<GLA, M3> C; C.dsum = 0.f; C.lb = 0.f;
    {
        const int lane = pg8::fresh_lane(), tid = wave * 64 + lane, fr = lane & 15, fq = lane >> 4;
        raw_issue<GLA, M3>(ar, wave, lane, Z, GAg, zero_page, sc * SUPER * CHUNK, hu, 0);
        if (!GLA) { const int ch = hu * 128 + (tid & 127); float lg[DEPTH], mxv = -1e30f;
#pragma unroll
            for (int j = 0; j < DEPTH; ++j) { lg[j] = a.lb_logits[j * HGW + ch]; mxv = fmaxf(mxv, lg[j]); }
            float den = 0.f, num = 0.f;
#pragma unroll
            for (int j = 0; j < DEPTH; ++j) { const float e = __expf(lg[j] - mxv); den += e; if (j >= 1 && j <= l) num += e; }
            C.lb = num / den; }
        if (M3) {
            const size_t supbase = (size_t)sc * E_TOTAL + (GLA ? (131072 + hu * 32768) : (hu * 16384));
#pragma unroll
            for (int jv = 0; jv < NVT; ++jv)
#pragma unroll
                for (int k4 = 0; k4 < 4; ++k4) C.S[jv][k4] = *(const v4u*)(SSUP + supbase + st_off<DV>((wave + 8 * jv) * 16 + fr, k4, fq));
        } else {
#pragma unroll
            for (int vt = 0; vt < DV / 16; ++vt) C.acc[vt] = (f32x4){0.f, 0.f, 0.f, 0.f};
        }
    }
#pragma unroll 1
    for (int j = 0; j < SUPER; ++j) { const int lane = pg8::fresh_lane();
        mix_step<GLA, M3>(a, ar, wave, lane, l, sc * SUPER + j, hu, j, j + 1 < SUPER, sc * SUPER + j + 1, hu, Z, GAg, zero_page, SB, SSUP, DSUP, Y, C); }
    wg_sync();
}
template <bool M3>
__device__ __forceinline__ void mix_phase(const Args& a, LAS unsigned char* lds, const int wave, const int l, const bf16* Z, const float* GAg, bf16* SB, bf16* SSUP, float* DSUP, bf16* Y) {
    LAS unsigned char* ar = lds + AR;
    const unsigned char* zero_page = a.ws + WS_CTL + 512 * 1024;
    for (int w = blockIdx.x; w < NSUPER * 4; w += gridDim.x) {
        const int sc = w >> 2, s = w & 3;
#pragma unroll 1
        for (int k = 0; k < 3; ++k) { int which = k + (w % 3); which = which >= 3 ? which - 3 : which;
            if (which == 2) mix_head<true, M3>(a, ar, wave, l, sc, s, Z, GAg, zero_page, SB, SSUP, DSUP, Y);
            else mix_head<false, M3>(a, ar, wave, l, sc, 2 * s + which, Z, GAg, zero_page, SB, SSUP, DSUP, Y); }
    }
}

__device__ __forceinline__ void scan_phase(const int wave, bf16* SSUP, const float* DSUP) {
    const int lane = pg8::fresh_lane(), tid = wave * 64 + lane;
    for (int e2 = blockIdx.x * 512 + tid; e2 < E_TOTAL / 2; e2 += gridDim.x * 512) {
        const int e = e2 * 2; int ch;
        if (e < 131072) ch = (e >> 14) * 128 + (((e & 16383) >> 11) << 4) + (e & 15); else { const int e3 = e - 131072; ch = 1024 + (e3 >> 15) * 128 + (((e3 & 32767) >> 12) << 4) + (e3 & 15); }
        float S0 = 0.f, S1 = 0.f;
        constexpr int U = 16;
#pragma unroll 1
        for (int cb = 0; cb < NSUPER; cb += U) {
            unsigned d[U]; f32x2v dd[U];
#pragma unroll
            for (int u = 0; u < U; ++u) { d[u] = *(const unsigned*)(SSUP + (size_t)(cb + u) * E_TOTAL + e); dd[u] = *(const f32x2v*)(DSUP + (size_t)(cb + u) * 1536 + ch); }
#pragma unroll
            for (int u = 0; u < U; ++u) {
                *(unsigned*)(SSUP + (size_t)(cb + u) * E_TOTAL + e) = pk(S0, S1);
                S0 = dd[u][0] * S0 + pg8::bf_lo(d[u]); S1 = dd[u][1] * S1 + pg8::bf_hi(d[u]); }
        }
    }
}
}

template <int DV>
__device__ __forceinline__ void naive_scan_batch(const LAS float* q, const LAS float* f, const LAS float* k, const LAS float* v, float (&S)[128], float* obuf_col, int t0, int col) {
#pragma unroll 1
    for (int tt = 0; tt < 16; ++tt) {
        const float vv = v[tt * DV + col]; float o = 0.f;
#pragma unroll
        for (int c = 0; c < 128; c += 4) {
            const f32x4 ff = *(const LAS f32x4*)(f + tt * 128 + c), kk = *(const LAS f32x4*)(k + tt * 128 + c), qq = *(const LAS f32x4*)(q + tt * 128 + c);
#pragma unroll
            for (int j = 0; j < 4; ++j) { S[c + j] = ff[j] * S[c + j] + kk[j] * vv; o += qq[j] * S[c + j]; }
        }
        obuf_col[(size_t)(t0 + tt) * 2048] = o;
    }
}
__device__ __forceinline__ void naive_recurrence(const Args& a, Frame& F, int l, const bf16* Z, const float* GA, float* OBUF) {
    const int b = blockIdx.x; if (b >= 12) return;
    LAS float* q = (LAS float*)(F.lds); LAS float* f = q + 16 * 128; LAS float* k = f + 16 * 128; LAS float* v = k + 16 * 128;
    LAS float* lbv = v + 16 * 256;
    float S[128];
#pragma unroll
    for (int c = 0; c < 128; ++c) S[c] = 0.f;
    if (b < 8) {
        const int hh = b;
        if (F.tid < 128) { const int ch = hh * 128 + F.tid; float lg[DEPTH], mx = -1e30f;
#pragma unroll
            for (int j = 0; j < DEPTH; ++j) { lg[j] = a.lb_logits[j * HGW + ch]; mx = fmaxf(mx, lg[j]); }
            float den = 0.f, num = 0.f;
#pragma unroll
            for (int j = 0; j < DEPTH; ++j) { const float e = __expf(lg[j] - mx); den += e; if (j >= 1 && j <= l) num += e; }
            lbv[F.tid] = num / den; }
        __syncthreads();
        for (int t0 = 0; t0 < M; t0 += 16) {
#pragma unroll
            for (int i = 0; i < 4; ++i) { const int idx = F.tid + 512 * i, tt = idx >> 7, c = idx & 127; const bf16* zr = Z + (size_t)(t0 + tt) * ZW + hh * 128 + c;
                const float zq = bf2f(zr[ZC_HQ]), zf = bf2f(zr[ZC_HF]), zi = bf2f(zr[ZC_HI]); const float lb = lbv[c];
                const float ff = lb + (1.f - lb) * sigmoidf_(zf);
                q[idx] = zq; f[idx] = ff; k[idx] = 1.f - ff; v[idx] = zi; }
            __syncthreads();
            if (F.tid < 128) naive_scan_batch<128>(q, f, k, v, S, OBUF + hh * 128 + F.tid, t0, F.tid);
            __syncthreads();
        }
    } else {
        const int g = b - 8; const float* cw = a.conv_w + (size_t)l * 4 * CONVC; const float* wg = a.w_gate + (size_t)l * GRANK * GKW; const float* bg = a.b_gate + (size_t)l * GKW;
        for (int t0 = 0; t0 < M; t0 += 16) {
#pragma unroll 1
            for (int i = 0; i < 16; ++i) { const int idx = F.tid + 512 * i, tt = idx >> 9, cc = idx & 511;
                int ch; if (cc < 128) ch = g * 128 + cc; else if (cc < 256) ch = 512 + g * 128 + (cc - 128); else ch = 1024 + g * 256 + (cc - 256);
                const int t = t0 + tt; float s = 0.f;
#pragma unroll
                for (int j = 0; j < 4; ++j) { const int ts = t - 3 + j; if (ts >= 0) s += cw[j * CONVC + ch] * bf2f(Z[(size_t)ts * ZW + ZC_GQ + ch]); }
                s = siluf_(s);
                if (cc < 128) q[tt * 128 + cc] = s * 0.08838834764831845f; else if (cc < 256) k[tt * 128 + cc - 128] = s; else v[tt * 256 + cc - 256] = s; }
#pragma unroll
            for (int i = 0; i < 4; ++i) { const int idx = F.tid + 512 * i, tt = idx >> 7, c = idx & 127; float xg = bg[g * 128 + c];
#pragma unroll
                for (int r = 0; r < GRANK; ++r) xg += GA[(size_t)(t0 + tt) * GRANK + r] * wg[r * GKW + g * 128 + c];
                const float ls = fminf(xg, 0.f) - log1pf(__expf(-fabsf(xg)));
                f[idx] = __expf(ls * (1.0f / 16.0f)); }
            __syncthreads();
            if (F.tid < 256) naive_scan_batch<256>(q, f, k, v, S, OBUF + 1024 + g * 256 + F.tid, t0, F.tid);
            __syncthreads();
        }
    }
}
__device__ __forceinline__ void norm_gate_phase(const Args& a, Frame& F, int l, const bf16* Z, const float* OBUF, bf16* Y) {
    const float* ghg = a.g_hg + (size_t)l * HGW; const float* ggl = a.g_gla + (size_t)l * GLAW;
    for (int t = F.gw; t < M; t += F.NGW) {
        const float* orow = OBUF + (size_t)t * 2048; const bf16* zr = Z + (size_t)t * ZW; bf16* yr = Y + (size_t)t * 2048;
#pragma unroll 1
        for (int hh = 0; hh < HGH; ++hh) { const int c = hh * 128 + 2 * F.lane; const float o0 = orow[c], o1 = orow[c + 1];
            const float ms = wave_sum(o0 * o0 + o1 * o1) * (1.0f / 128.0f); const float r = __builtin_amdgcn_rsqf(ms + EPS);
            const float g0 = bf2f(zr[ZC_HG + c]), g1 = bf2f(zr[ZC_HG + c + 1]);
            *(unsigned*)(yr + c) = pk2(o0 * r * ghg[c] * siluf_(g0), o1 * r * ghg[c + 1] * siluf_(g1)); }
#pragma unroll 1
        for (int g = 0; g < GH; ++g) { const int c = g * 256 + 4 * F.lane; float o[4], ss = 0.f;
#pragma unroll
            for (int j = 0; j < 4; ++j) { o[j] = orow[1024 + c + j]; ss += o[j] * o[j]; }
            const float ms = wave_sum(ss) * (1.0f / 256.0f); const float r = __builtin_amdgcn_rsqf(ms + EPS); float y[4];
#pragma unroll
            for (int j = 0; j < 4; ++j) y[j] = o[j] * r * ggl[c + j] * siluf_(bf2f(zr[ZC_GR + c + j]));
            v2u w; w.x = pk2(y[0], y[1]); w.y = pk2(y[2], y[3]); *(v2u*)(yr + 1024 + c) = w; }
    }
}
__device__ __forceinline__ void final_norm(const Args& a, Frame& F, const float* stats, const bf16* hb) {
    const GAS f32x4* gr = (const GAS f32x4*)a.g_final;
    f32x4 g0[4], g1[4];
#pragma unroll
    for (int j = 0; j < 4; ++j) { const int c4 = (64 * j + F.lane) * 2; g0[j] = gr[c4]; g1[j] = gr[c4 + 1]; }
    for (int m = F.gw; m < M; m += F.NGW) {
        GAS f32x4* orow = (GAS f32x4*)(a.out + (size_t)m * D);
        v4u h[4];
#pragma unroll
        for (int j = 0; j < 4; ++j) h[j] = *(const GAS v4u*)(hb + pg8::tile_rc(m, 8 * (F.lane + 64 * j), D));
        float sv = (F.lane < 32) ? stats[(size_t)m * 32 + F.lane] : 0.f; sv = wave_sum(sv);
        const float rstd = __builtin_amdgcn_rsqf(sv * (1.0f / D) + EPS);
#pragma unroll
        for (int j = 0; j < 4; ++j) { const int c4 = (64 * j + F.lane) * 2;
            const f32x4 o0 = {pg8::bf_lo(h[j].x), pg8::bf_hi(h[j].x), pg8::bf_lo(h[j].y), pg8::bf_hi(h[j].y)}, o1 = {pg8::bf_lo(h[j].z), pg8::bf_hi(h[j].z), pg8::bf_lo(h[j].w), pg8::bf_hi(h[j].w)};
            orow[c4] = o0 * rstd * g0[j]; orow[c4 + 1] = o1 * rstd * g1[j]; }
    }
}
__device__ __forceinline__ int fresh_bx() { int b = blockIdx.x; asm volatile("" : "+s"(b)); return b; }
constexpr int PH_PER_LAYER = 8;
constexpr int N_PHASES = 1 + DEPTH * PH_PER_LAYER + 1;

__global__ void __launch_bounds__(NWAVES * 64, 2) hyb_fwd(Args args) {
    extern __shared__ __attribute__((aligned(16))) unsigned char lds[];
    const int wave_s = __builtin_amdgcn_readfirstlane((int)threadIdx.x >> 6);
#define MKFRAME() Frame F; { F.lds = (LAS unsigned char*)lds; F.lane = pg8::fresh_lane(); F.wave = wave_s; F.tid = wave_s * 64 + F.lane; \
        F.G = gridDim.x; F.gw = blockIdx.x * NWAVES + F.wave; F.NGW = F.G * NWAVES; }
    LAS unsigned char* const ldsb = (LAS unsigned char*)lds;
    LAS float* const RTAB = (LAS float*)(ldsb + RTAB_OFF);
    volatile LAS unsigned* MISC = (volatile LAS unsigned*)(ldsb + MISC_OFF);
    for (int u = threadIdx.x; u < LDSCTL_BYTES / 4; u += NWAVES * 64) ((LAS unsigned*)(ldsb + LDSCTL_OFF))[u] = 0u;
    __syncthreads();
#define BARW ((unsigned*)(args.ws + WS_CTL) + CW_BAR)
    XcdBarrier bar; bar.bar = nullptr; bar.x = 0; bar.st = nullptr;
    const int lo = args.ph_lo, hi = args.ph_hi;

    if (hi - lo > 1) { bar = xcd_barrier_post(BARW, MISC + 8); bar.bar = nullptr; }
#define IN(k) (lo <= (k) && (k) < hi)
#define SEAM(k) do { if (IN(k) && IN((k) + 1)) { xcd_barrier(bar, BARW); for (int pb_ = 0; pb_ < PROBE_BAR; ++pb_) xcd_barrier(bar, BARW); } } while (0)

    if (IN(0)) { MKFRAME(); for (int pr_ = 0; pr_ <= PROBE_PRO; ++pr_) prologue(args, F); SEAM(0); }

#define PH_PTRS() GAS unsigned char* wsg_ = (GAS unsigned char*)args.ws; asm volatile("" : "+s"(wsg_)); unsigned char* ws = (unsigned char*)wsg_;     \
    float* const st_mix = (float*)(ws + WS_STATS); float* const st_mlp = (float*)(ws + WS_STATS + STATS_BYTES); float* const st_ple = (float*)(ws + WS_STATS + 2 * STATS_BYTES); \
    bf16* const Z = (bf16*)(ws + WS_UNION + UO_Z); bf16* const ABUF = (bf16*)(ws + WS_UNION + UO_A); bf16* const PP = (bf16*)(ws + WS_UNION + UO_PP); unsigned char* const H8 = ws + WS_UNION + UO_H8; \
    float* const GA = (float*)(ws + WS_GA); bf16* const PB = (bf16*)(ws + WS_PB); \
    bf16* const SB = (bf16*)(ws + WS_UNION + UO_S); bf16* const SSUP = (bf16*)(ws + WS_UNION + UO_SSUP); float* const DSUP = (float*)(ws + WS_DEC); \
    bf16* const hb = (bf16*)(ws + ((l & 1) ? WS_HBB : WS_HBA)); bf16* const yb = (bf16*)(ws + ((l & 1) ? WS_HBA : WS_HBB)); \
    unsigned char* const wl = ws + WS_W + (size_t)l * W_LAYER; \
    (void)H8; (void)st_mix; (void)st_mlp; (void)st_ple; (void)Z; (void)ABUF; (void)PP; (void)GA; (void)PB; (void)SB; (void)SSUP; (void)DSUP; (void)hb; (void)yb; (void)wl;

#pragma unroll 1
    for (int l = 0; l < DEPTH; ++l) {
        const int pbase = 1 + l * PH_PER_LAYER;

        if (IN(pbase + 0)) { PH_PTRS();
            pg8::Gemm g{hb, (const bf16*)(wl + WO_IN), M, ZW, D}; pg8::StaticOrder S; S.init(M, ZW, (int)gridDim.x, fresh_bx());
            pg8::EpiScaleBf16<0, true> E{Z, ZW, st_mix, RTAB};
            for (int pr_ = 0; pr_ < PROBE_GEMM; ++pr_) { pg8::EpiNull EN; pg8::gemm_phase<pg8::EpiNull, pg8::StaticOrder, PG8_ALIGN, PG8_SP2>(ldsb + RING_OFF, wave_s, g, S, EN); }
            for (int pq_ = 0; pq_ <= PROBE_GEMMR; ++pq_) pg8::gemm_phase<pg8::EpiScaleBf16<0, true>, pg8::StaticOrder, PG8_ALIGN, PG8_SP2, false, true>(ldsb + RING_OFF, wave_s, g, S, E);
            { MKFRAME(); ga_phase(args, F, hb, (const bf16*)(wl + WO_GA), st_mix, GA); }
            SEAM(pbase + 0);
        }
        if (IN(pbase + 1)) { PH_PTRS(); { MKFRAME(); pb_phase(args, F, l); } for (int pr_ = 0; pr_ <= PROBE_MIX; ++pr_) mx::mix_phase<false>(args, ldsb, wave_s, l, Z, GA, SB, SSUP, DSUP, yb); SEAM(pbase + 1); }
        if (IN(pbase + 2)) { PH_PTRS(); mx::scan_phase(wave_s, SSUP, DSUP); SEAM(pbase + 2); }
        if (IN(pbase + 3)) { PH_PTRS(); for (int pr_ = 0; pr_ <= PROBE_MIX; ++pr_) mx::mix_phase<true>(args, ldsb, wave_s, l, Z, GA, SB, SSUP, DSUP, yb); SEAM(pbase + 3); }
        if (IN(pbase + 4)) { PH_PTRS();
            pg8::Gemm g{yb, (const bf16*)(wl + WO_OUT), M, D, D}; pg8::StaticOrder S; S.init(M, D, (int)gridDim.x, fresh_bx());
            pg8::EpiResidual<0> E{hb, hb, st_mlp, nullptr, nullptr, D, RTAB, nullptr};
            for (int pr_ = 0; pr_ < PROBE_GEMM; ++pr_) { pg8::EpiNull EN; pg8::gemm_phase<pg8::EpiNull, pg8::StaticOrder, PG8_ALIGN, PG8_SP2>(ldsb + RING_OFF, wave_s, g, S, EN); }
            pg8::gemm_phase<pg8::EpiResidual<0>, pg8::StaticOrder, PG8_ALIGN, PG8_SP2, false, true>(ldsb + RING_OFF, wave_s, g, S, E);
            SEAM(pbase + 4);
        }
        if (IN(pbase + 5)) { PH_PTRS();
            { pg8::Gemm g{hb, (const bf16*)(wl + WO_UP), M, FF, D}; pg8::StaticOrder S; S.init(M, FF, (int)gridDim.x, fresh_bx());
              pg8::EpiScaleBf16<1, true> E{ABUF, FF, st_mlp, RTAB};
              for (int pr_ = 0; pr_ < PROBE_GEMM; ++pr_) { pg8::EpiNull EN; pg8::gemm_phase<pg8::EpiNull, pg8::StaticOrder, PG8_ALIGN, PG8_SP2>(ldsb + RING_OFF, wave_s, g, S, EN); }
            for (int pq_ = 0; pq_ <= PROBE_GEMMR; ++pq_) pg8::gemm_phase<pg8::EpiScaleBf16<1, true>, pg8::StaticOrder, PG8_ALIGN, PG8_SP2, false, true>(ldsb + RING_OFF, wave_s, g, S, E); }
            SEAM(pbase + 5);
        }
        if (IN(pbase + 6)) { PH_PTRS();
            pg8::Gemm g{ABUF, (const bf16*)(wl + WO_DN), M, D, FF}; pg8::StaticOrder S; S.init(M, D, (int)gridDim.x, fresh_bx(), 4);
            pg8::EpiResidual<2> E{hb, hb, st_ple, nullptr, nullptr, D, RTAB, H8};
            for (int pr_ = 0; pr_ < PROBE_GEMM; ++pr_) { pg8::EpiNull EN; pg8::gemm_phase<pg8::EpiNull, pg8::StaticOrder, PG8_ALIGN, PG8_SP2>(ldsb + RING_OFF, wave_s, g, S, EN); }
            pg8::gemm_phase<pg8::EpiResidual<2>, pg8::StaticOrder, PG8_ALIGN, PG8_SP2, false, true>(ldsb + RING_OFF, wave_s, g, S, E);
            SEAM(pbase + 6);
        }
        if (IN(pbase + 7)) { PH_PTRS();
            { pg8::Gemm g{PB, (const bf16*)(wl + WO_PP), M, D, PLE}; pg8::StaticOrder S; S.init(M, D, (int)gridDim.x, fresh_bx());
              pg8::EpiScaleBf16<2, true> E{PP, D, nullptr, RTAB};
              for (int pr_ = 0; pr_ < PROBE_GEMM; ++pr_) { pg8::EpiNull EN; pg8::gemm_phase<pg8::EpiNull, pg8::StaticOrder, PG8_ALIGN, PG8_SP2>(ldsb + RING_OFF, wave_s, g, S, EN); }
            for (int pq_ = 0; pq_ <= PROBE_GEMMR; ++pq_) pg8::gemm_phase<pg8::EpiScaleBf16<2, true>, pg8::StaticOrder, PG8_ALIGN, PG8_SP2>(ldsb + RING_OFF, wave_s, g, S, E); }
            pg8::Gemm g{(const bf16*)H8, (const bf16*)(wl + WO_PG), M, D, D / 2}; pg8::StaticOrder S; S.init(M, D, (int)gridDim.x, fresh_bx());
            pg8::EpiResidual<1> E{hb, yb, st_mix, st_ple, PP, D, RTAB, nullptr};
            for (int pr_ = 0; pr_ < PROBE_GEMM; ++pr_) { pg8::EpiNull EN; pg8::gemm_phase<pg8::EpiNull, pg8::StaticOrder, PG8_ALIGN, PG8_SP2, true>(ldsb + RING_OFF, wave_s, g, S, EN); }
            int np5_ = PROBE_G5 + 1; asm volatile("" : "+s"(np5_));
#pragma unroll 1
            for (int pq_ = 0; pq_ < np5_; ++pq_) pg8::gemm_phase<pg8::EpiResidual<1>, pg8::StaticOrder, PG8_ALIGN, PG8_SP2, true, true>(ldsb + RING_OFF, wave_s, g, S, E);
            SEAM(pbase + 7);
        }
    }
    if (IN(N_PHASES - 1)) { const int l = DEPTH; PH_PTRS(); MKFRAME(); final_norm(args, F, st_mix, hb); }

#undef IN
#undef SEAM
}

extern "C" void kernel_launch(void* const* d_in, const int* in_sizes, int n_in, void* d_out, int out_size, void* d_ws, size_t ws_size, hipStream_t stream) {
    static int grid = 0;
    if (grid == 0) {
        if (n_in != 18 || out_size != M * D || ws_size < WS_END) { fprintf(stderr, "kernel_launch: unexpected shapes (n_in %d out %d ws %zu, need %zu); nothing launched\n", n_in, out_size, ws_size, (size_t)WS_END); grid = -1; return; }
        int dev = 0, cus = 0, per_cu = 0;
        if (hipGetDevice(&dev) != hipSuccess || hipDeviceGetAttribute(&cus, hipDeviceAttributeMultiprocessorCount, dev) != hipSuccess) { grid = -1; return; }
        if (hipFuncSetAttribute((const void*)hyb_fwd, hipFuncAttributeMaxDynamicSharedMemorySize, LDS_BYTES) != hipSuccess) { fprintf(stderr, "kernel_launch: hipFuncSetAttribute failed\n"); grid = -1; return; }
        if (hipOccupancyMaxActiveBlocksPerMultiprocessor(&per_cu, (const void*)hyb_fwd, NWAVES * 64, LDS_BYTES) != hipSuccess || per_cu < 1) { fprintf(stderr, "kernel_launch: occupancy query says %d\n", per_cu); }
        (void)hipGetLastError();
        grid = cus;
    }
    if (grid < 0) return;
    if (hipMemsetAsync((char*)d_ws + WS_CTL, 0, CTL_ZERO_BYTES, stream) != hipSuccess) return;
    Args a{};
    const float** pa = (const float**)&a;
    for (int i = 0; i < 18; ++i) pa[i] = (const float*)d_in[i];
    a.out = (float*)d_out; a.ws = (unsigned char*)d_ws;
#if MK_MULTI
    for (int ph = 0; ph < N_PHASES; ++ph) { a.ph_lo = ph; a.ph_hi = ph + 1; hipLaunchKernelGGL(hyb_fwd, dim3(grid), dim3(NWAVES * 64), LDS_BYTES, stream, a); }
#else
    a.ph_lo = 0; a.ph_hi = N_PHASES;
    hipLaunchKernelGGL(hyb_fwd, dim3(grid), dim3(NWAVES * 64), LDS_BYTES, stream, a);
#endif
}
```
